# Optimizing an MI355X kernel written in HIP

```python
import jax, jax.numpy as jnp
from jax import lax
import numpy as np

D_MODEL = 2048
BATCH = 8
SEQ = 2048
DEPTH = 2

GRID_W = 64
CTX_LEN = 256
N_MIXERS = 2
N_SUB = 3
D_FF = 5632
MACARON = 0.5
LRU_WIDTH = D_MODEL
LRU_HEADS = 16
LRU_BLOCK = LRU_WIDTH // LRU_HEADS
CONV_W = 4
RG_C = 8.0
N_FGROUPS = 8
FGROUP = D_MODEL // N_FGROUPS
N_REC = (DEPTH + 1) // 2
N_FOU = DEPTH // 2
EPS = 1e-6

kernel_name = 'hybrid_rglru_fnet_macaron_dit'


def rmsnorm(x, g):
    xf = x.astype(jnp.float32)
    y = xf * lax.rsqrt(jnp.mean(xf * xf, axis=-1, keepdims=True) + EPS)
    return (y * g.astype(jnp.float32)).astype(x.dtype)


def modulate(h, shift, scale):
    return h * (1 + scale) + shift


def adaln(cvec, w, b):
    m = (jax.nn.silu(cvec) @ w + b)[:, None, :]
    return jnp.split(m, 3 * N_SUB, axis=-1)


def swiglu(h, w_in, w_out):
    gate, up = jnp.split(h @ w_in, 2, axis=-1)
    return (jax.nn.silu(gate) * up) @ w_out


def ffn_sublayer(x, g_pre, g_post, shift, scale, gate, w_in, w_out):
    y = swiglu(modulate(rmsnorm(x, g_pre), shift, scale), w_in, w_out)
    return x + MACARON * gate * rmsnorm(y, g_post)


def centred_dwconv(v, w, b, axis):
    n = v.shape[axis]
    left = CONV_W // 2
    pad = [(0, 0)] * v.ndim
    pad[axis] = (left, CONV_W - 1 - left)
    vp = jnp.pad(v, pad)
    out = b
    for k in range(CONV_W):
        out = out + w[k] * lax.slice_in_dim(vp, k, k + n, axis=axis)
    return out


def block_diag(v, w, b):
    bsz, n, r = v.shape
    y = jnp.einsum('blhi,hij->blhj', v.reshape(bsz, n, LRU_HEADS, LRU_BLOCK), w)
    return y.reshape(bsz, n, r) + b


def rglru_coeffs(v, wa, ba, wx, bx, lam):
    r = jax.nn.sigmoid(block_diag(v, wa, ba)).astype(jnp.float32)
    i = jax.nn.sigmoid(block_diag(v, wx, bx)).astype(jnp.float32)
    log_a = -RG_C * r * jax.nn.softplus(-lam.astype(jnp.float32))
    a = jnp.exp(log_a)
    mult = jnp.sqrt(-jnp.expm1(2.0 * log_a))
    return a, mult * i * v.astype(jnp.float32)


def linear_scan(a, b, h0, reverse):
    def comb(lhs, rhs):
        a1, b1 = lhs
        a2, b2 = rhs
        return a1 * a2, a2 * b1 + b2
    a_cum, b_cum = lax.associative_scan(comb, (a, b), axis=1, reverse=reverse)
    return a_cum * h0[:, None, :] + b_cum


def rglru_mixer(h_lat, h_ctx, rows, w_in, conv_w, conv_b, gate_w, gate_b, lam, w_out, need_ctx_out):
    bsz, n, _ = h_lat.shape
    g_lat, v_lat = jnp.split(h_lat @ w_in, 2, axis=-1)
    v_lat = centred_dwconv(v_lat.reshape(bsz, rows, GRID_W, LRU_WIDTH), conv_w, conv_b, axis=2)
    v_lat = v_lat.reshape(bsz, n, LRU_WIDTH)
    v_ctx = centred_dwconv(h_ctx @ w_in[:, LRU_WIDTH:], conv_w, conv_b, axis=1)
    zeros = jnp.zeros((bsz, LRU_WIDTH), jnp.float32)
    y_lat = jnp.zeros((bsz, n, LRU_WIDTH), jnp.float32)
    y_ctx = jnp.zeros(v_ctx.shape, jnp.float32)
    for d, reverse in enumerate((False, True)):
        a_c, b_c = rglru_coeffs(v_ctx, gate_w[d, 0], gate_b[d, 0], gate_w[d, 1], gate_b[d, 1], lam[d])
        h_c = linear_scan(a_c, b_c, zeros, reverse)
        h_end = h_c[:, 0] if reverse else h_c[:, -1]
        a_l, b_l = rglru_coeffs(v_lat, gate_w[d, 0], gate_b[d, 0], gate_w[d, 1], gate_b[d, 1], lam[d])
        y_lat = y_lat + linear_scan(a_l, b_l, h_end, reverse)
        if need_ctx_out:
            y_ctx = y_ctx + h_c
    out_lat = (jax.nn.gelu(g_lat) * y_lat.astype(h_lat.dtype)) @ w_out
    out_ctx = None
    if need_ctx_out:
        g_ctx = h_ctx @ w_in[:, :LRU_WIDTH]
        out_ctx = (jax.nn.gelu(g_ctx) * y_ctx.astype(h_ctx.dtype)) @ w_out
    return out_lat, out_ctx


def fourier_mixer(h, w_out):
    bsz, n, _ = h.shape
    hg = h.reshape(bsz, n, N_FGROUPS, FGROUP).astype(jnp.float32)
    f = jnp.fft.fftn(hg, axes=(1, 3), norm='ortho').real
    return f.reshape(bsz, n, D_MODEL).astype(h.dtype) @ w_out


def setup_inputs(seed: int = 0) -> dict:
    key = jax.random.key(seed)
    ks = jax.random.split(key, 20)
    f32 = jnp.float32
    x = jax.random.normal(ks[0], (BATCH, SEQ, D_MODEL), f32)
    c = jax.random.normal(ks[1], (BATCH, D_MODEL), f32)
    ctx = jax.random.normal(ks[2], (BATCH, CTX_LEN, D_MODEL), f32)
    c_ctx = jax.random.normal(ks[3], (D_MODEL,), f32)
    mod_w = jax.random.normal(ks[4], (DEPTH, D_MODEL, 3 * N_SUB * D_MODEL), f32) * (0.5 * D_MODEL ** -0.5)
    mod_b = jax.random.normal(ks[5], (DEPTH, 3 * N_SUB * D_MODEL), f32) * 0.01
    norm_g = 1.0 + 0.01 * jax.random.normal(ks[6], (DEPTH, 2 * N_SUB, D_MODEL), f32)
    ffn_w_in = jax.random.normal(ks[7], (DEPTH, 2, D_MODEL, 2 * D_FF), f32) * D_MODEL ** -0.5
    ffn_w_out = jax.random.normal(ks[8], (DEPTH, 2, D_FF, D_MODEL), f32) * D_FF ** -0.5
    rec_w_in = jax.random.normal(ks[9], (N_REC, D_MODEL, 2 * LRU_WIDTH), f32) * D_MODEL ** -0.5
    rec_conv_w = jax.random.normal(ks[10], (N_REC, CONV_W, LRU_WIDTH), f32) * CONV_W ** -0.5
    rec_conv_b = jax.random.normal(ks[11], (N_REC, LRU_WIDTH), f32) * 0.01
    rec_gate_w = jax.random.normal(ks[12], (N_REC, 2, 2, LRU_HEADS, LRU_BLOCK, LRU_BLOCK), f32) * LRU_BLOCK ** -0.5
    rec_gate_b = jax.random.normal(ks[13], (N_REC, 2, 2, LRU_WIDTH), f32) * 0.01
    a_target = jax.random.uniform(ks[14], (N_REC, 2, LRU_WIDTH), f32, minval=0.9, maxval=0.999)
    s = a_target ** (1.0 / RG_C)
    rec_lam = jnp.log(s) - jnp.log1p(-s)
    rec_w_out = jax.random.normal(ks[15], (N_REC, LRU_WIDTH, D_MODEL), f32) * LRU_WIDTH ** -0.5
    fou_w_out = jax.random.normal(ks[16], (N_FOU, D_MODEL, D_MODEL), f32) * D_MODEL ** -0.5
    return {'x': x, 'c': c, 'ctx': ctx, 'c_ctx': c_ctx, 'mod_w': mod_w, 'mod_b': mod_b,
            'norm_g': norm_g, 'ffn_w_in': ffn_w_in, 'ffn_w_out': ffn_w_out,
            'rec_w_in': rec_w_in, 'rec_conv_w': rec_conv_w, 'rec_conv_b': rec_conv_b,
            'rec_gate_w': rec_gate_w, 'rec_gate_b': rec_gate_b, 'rec_lam': rec_lam,
            'rec_w_out': rec_w_out, 'fou_w_out': fou_w_out}


def reference(x, c, ctx, c_ctx, mod_w, mod_b, norm_g, ffn_w_in, ffn_w_out, rec_w_in, rec_conv_w,
              rec_conv_b, rec_gate_w, rec_gate_b, rec_lam, rec_w_out, fou_w_out):
    rows = x.shape[1] // GRID_W
    last_rec = ((DEPTH - 1) // N_MIXERS) * N_MIXERS
    for i in range(DEPTH):
        is_rec = (i % N_MIXERS) == 0
        j = i // N_MIXERS
        ctx_used = i <= last_rec
        ctx_full = i < last_rec
        g = norm_g[i]
        sh1, sc1, gt1, sh2, sc2, gt2, sh3, sc3, gt3 = adaln(c, mod_w[i], mod_b[i])
        x = ffn_sublayer(x, g[0], g[1], sh1, sc1, gt1, ffn_w_in[i, 0], ffn_w_out[i, 0])
        hc = None
        if ctx_used:
            m_ctx = adaln(c_ctx[None], mod_w[i], mod_b[i])
            ctx = ffn_sublayer(ctx, g[0], g[1], m_ctx[0], m_ctx[1], m_ctx[2], ffn_w_in[i, 0], ffn_w_out[i, 0])
            hc = modulate(rmsnorm(ctx, g[2]), m_ctx[3], m_ctx[4])
        hx = modulate(rmsnorm(x, g[2]), sh2, sc2)
        if is_rec:
            y, yc = rglru_mixer(hx, hc, rows, rec_w_in[j], rec_conv_w[j], rec_conv_b[j], rec_gate_w[j],
                                rec_gate_b[j], rec_lam[j], rec_w_out[j], ctx_full)
        else:
            y = fourier_mixer(hx, fou_w_out[j])
            yc = fourier_mixer(hc, fou_w_out[j]) if ctx_full else None
        x = x + gt2 * rmsnorm(y, g[3])
        x = ffn_sublayer(x, g[4], g[5], sh3, sc3, gt3, ffn_w_in[i, 1], ffn_w_out[i, 1])
        if ctx_full:
            ctx = ctx + m_ctx[5] * rmsnorm(yc, g[3])
            ctx = ffn_sublayer(ctx, g[4], g[5], m_ctx[6], m_ctx[7], m_ctx[8], ffn_w_in[i, 1], ffn_w_out[i, 1])
    return x
```

```cpp
#include <hip/hip_runtime.h>
#include <cstdio>
#include <cstdint>

namespace pg8 {
#define PG8_LAS __attribute__((address_space(3)))
typedef unsigned short bf16_t;
typedef short bf16x8 __attribute__((ext_vector_type(8)));
typedef float f32x4 __attribute__((ext_vector_type(4)));
typedef unsigned u32x4 __attribute__((ext_vector_type(4)));
constexpr int BM = 256, BK = 64, HALF = 128, HTB = HALF * BK * 2  , STAGE_BYTES = 8 * HTB, NXCD = 8, WGM = 8;

__host__ __device__ __forceinline__ int lds_byte(int r, int c) { const int st = (r >> 4) * 2 + (c >> 5), rr = r & 15, cc = c & 31, ob = rr * 64 + cc * 2; return st * 1024 + (ob ^ (((ob >> 9) & 1) << 5)); }
__host__ __device__ __forceinline__ void stage_rc(int b, int& R, int& C) { const int st = b / 1024, sb = b % 1024, swz = sb ^ (((sb >> 9) & 1) << 5); R = (st >> 1) * 16 + swz / 64; C = (st & 1) * 32 + (swz % 64) / 2; }
__host__ __device__ __forceinline__ int perm32(int rho) { const int n = rho >> 4, i = rho & 15; return 8 * (i >> 2) + 4 * n + (i & 3); }

struct Unit { int pm, pn, z; };
struct Gemm { const bf16_t* A; const bf16_t* Bt; int lda, ldb, K, zdiv; long a_s1, a_s0, b_s1, b_s0;
    __device__ __forceinline__ const char* baseA(const Unit& u) const { return (const char*)A + (long)(u.z / zdiv) * a_s1 + (long)(u.z % zdiv) * a_s0; }
    __device__ __forceinline__ const char* baseB(const Unit& u) const { return (const char*)Bt + (long)(u.z / zdiv) * b_s1 + (long)(u.z % zdiv) * b_s0; } };

struct BatchOrder {
    int nM, nN, per, nwg, G, c;
    __host__ __device__ void init(int M, int N, int nz, int G_, int c_) { nM = M / BM; nN = N / BM; per = nM * nN; nwg = per * nz; G = G_; c = c_; }
    __host__ __device__ bool next(int i, Unit& u) const {
        const long L = (long)i * G + c; if (L >= nwg) return false;
        int wgid = (int)L; { const int q = nwg / NXCD, r = nwg % NXCD, xcd = wgid % NXCD, off = wgid / NXCD; wgid = (xcd < r ? xcd * (q + 1) : r * (q + 1) + (xcd - r) * q) + off; }
        u.z = wgid / per; const int w = wgid % per;
        const int nig = WGM * nN, gid = w / nig, fm = gid * WGM, gsz = (nM - fm) < WGM ? (nM - fm) : WGM;
        u.pm = fm + ((w % nig) % gsz); u.pn = (w % nig) / gsz; return true;
    }
    __device__ __forceinline__ void a_ready(const Unit&) const {}
    __device__ __forceinline__ void done(const Unit&) const {}
};

__device__ __forceinline__ unsigned cvt_pk_bf16(float lo, float hi) { unsigned r; asm volatile("v_cvt_pk_bf16_f32 %0, %1, %2" : "=v"(r) : "v"(lo), "v"(hi)); return r; }
__device__ __forceinline__ float sigmoid_f(float x) { return __builtin_amdgcn_rcpf(1.0f + __builtin_amdgcn_exp2f(-1.4426950408889634f * x)); }
__device__ __forceinline__ float gelu_tanh_f(float x) { return x * sigmoid_f(1.5957691216057308f * (x + 0.044715f * x * x * x)); }

struct EpiF32 {
    static constexpr bool PERM = false, AFTER_DRAIN = false;
    float* C; int ldc;
    __device__ __forceinline__ void operator()(const f32x4 (&acc)[2][2][4][2], const Unit& u, int wr, int wc, int fr, int fq) const {
        const int row0 = u.pm * BM + wr * 64 + fr, col0 = u.pn * BM + wc * 32 + 4 * fq;
#pragma unroll
        for (int ai = 0; ai < 2; ++ai)
#pragma unroll
            for (int m = 0; m < 4; ++m) { float* rowp = C + (size_t)(row0 + ai * HALF + m * 16) * ldc + col0;
#pragma unroll
                for (int bj = 0; bj < 2; ++bj)
#pragma unroll
                    for (int n = 0; n < 2; ++n) *(f32x4*)(rowp + bj * HALF + n * 16) = acc[ai][bj][m][n]; }
    }
};
struct EpiSwiGLU {
    static constexpr bool PERM = true, AFTER_DRAIN = false;
    bf16_t* O; int ldc;
    __device__ __forceinline__ void operator()(const f32x4 (&acc)[2][2][4][2], const Unit& u, int wr, int wc, int fr, int fq) const {
        const int row0 = u.pm * BM + wr * 64 + fr, col0 = u.pn * HALF + wc * 32 + 8 * fq;
#pragma unroll
        for (int ai = 0; ai < 2; ++ai)
#pragma unroll
            for (int m = 0; m < 4; ++m) { bf16_t* rowp = O + (size_t)(row0 + ai * HALF + m * 16) * ldc + col0;
                float o[8];
#pragma unroll
                for (int n = 0; n < 2; ++n)
#pragma unroll
                    for (int j = 0; j < 4; ++j) { const float gv = acc[ai][0][m][n][j], uv = acc[ai][1][m][n][j]; o[4 * n + j] = gv * sigmoid_f(gv) * uv; }
                u32x4 w; w.x = cvt_pk_bf16(o[0], o[1]); w.y = cvt_pk_bf16(o[2], o[3]); w.z = cvt_pk_bf16(o[4], o[5]); w.w = cvt_pk_bf16(o[6], o[7]);
                *(u32x4*)rowp = w; }
    }
};
struct EpiGV {
    static constexpr bool PERM = true, AFTER_DRAIN = false;
    bf16_t* G; bf16_t* V;
    __device__ __forceinline__ void operator()(const f32x4 (&acc)[2][2][4][2], const Unit& u, int wr, int wc, int fr, int fq) const {
        const bool isg = u.pn < 8; bf16_t* base = isg ? G : V;
        const int row0 = u.pm * BM + wr * 64 + fr, col0 = (isg ? u.pn : u.pn - 8) * BM + wc * 32 + 8 * fq;
#pragma unroll
        for (int ai = 0; ai < 2; ++ai)
#pragma unroll
            for (int m = 0; m < 4; ++m) { bf16_t* rowp = base + (size_t)(row0 + ai * HALF + m * 16) * 2048 + col0;
#pragma unroll
                for (int bj = 0; bj < 2; ++bj) { f32x4 v0 = acc[ai][bj][m][0], v1 = acc[ai][bj][m][1];
                    if (isg) {
#pragma unroll
                        for (int j = 0; j < 4; ++j) { v0[j] = gelu_tanh_f(v0[j]); v1[j] = gelu_tanh_f(v1[j]); } }
                    u32x4 w; w.x = cvt_pk_bf16(v0[0], v0[1]); w.y = cvt_pk_bf16(v0[2], v0[3]); w.z = cvt_pk_bf16(v1[0], v1[1]); w.w = cvt_pk_bf16(v1[2], v1[3]);
                    *(u32x4*)(rowp + bj * HALF) = w; } }
    }
};
struct EpiBf16Z {
    static constexpr bool PERM = true, AFTER_DRAIN = false;
    bf16_t* O; int ldc; int roff_z; float scale;
    __device__ __forceinline__ void operator()(const f32x4 (&acc)[2][2][4][2], const Unit& u, int wr, int wc, int fr, int fq) const {
        const int row0 = u.z * roff_z + u.pm * BM + wr * 64 + fr, col0 = u.pn * BM + wc * 32 + 8 * fq;
#pragma unroll
        for (int ai = 0; ai < 2; ++ai)
#pragma unroll
            for (int m = 0; m < 4; ++m) { bf16_t* rowp = O + (size_t)(row0 + ai * HALF + m * 16) * ldc + col0;
#pragma unroll
                for (int bj = 0; bj < 2; ++bj) { const f32x4 v0 = acc[ai][bj][m][0] * scale, v1 = acc[ai][bj][m][1] * scale;
                    u32x4 w; w.x = cvt_pk_bf16(v0[0], v0[1]); w.y = cvt_pk_bf16(v0[2], v0[3]); w.z = cvt_pk_bf16(v1[0], v1[1]); w.w = cvt_pk_bf16(v1[2], v1[3]);
                    *(u32x4*)(rowp + bj * HALF) = w; } }
    }
};
struct EpiZT {
    static constexpr bool PERM = true, AFTER_DRAIN = false;
    bf16_t* ZT;
    __device__ __forceinline__ void operator()(const f32x4 (&acc)[2][2][4][2], const Unit& u, int wr, int wc, int fr, int fq) const {
        const int b = u.z >> 3, g = u.z & 7;
        bf16_t* base = ZT + ((size_t)b * 2048 + (size_t)g * 256) * 4096 + (size_t)u.pm * 2048;
        const int row0 = wr * 64 + fr, col0 = u.pn * BM + wc * 32 + 8 * fq;
#pragma unroll
        for (int ai = 0; ai < 2; ++ai)
#pragma unroll
            for (int m = 0; m < 4; ++m) { bf16_t* rowp = base + (size_t)(row0 + ai * HALF + m * 16) * 4096 + col0;
#pragma unroll
                for (int bj = 0; bj < 2; ++bj) { const f32x4 v0 = acc[ai][bj][m][0] * 0.0625f, v1 = acc[ai][bj][m][1] * 0.0625f;
                    u32x4 w; w.x = cvt_pk_bf16(v0[0], v0[1]); w.y = cvt_pk_bf16(v0[2], v0[3]); w.z = cvt_pk_bf16(v1[0], v1[1]); w.w = cvt_pk_bf16(v1[2], v1[3]);
                    *(u32x4*)(rowp + bj * HALF) = w; } }
    }
};

template <class Epi, class Sched, bool ALIGN_EPI = false, bool SP2 = false>
__device__ __forceinline__ void gemm_phase(PG8_LAS unsigned char* lds, const Gemm g, const Sched& S, const Epi& E) {
    int tid_ = threadIdx.x; asm volatile("" : "+v"(tid_));
    const int tid = tid_, wid = __builtin_amdgcn_readfirstlane(tid >> 6), lane = tid & 63, wr = wid >> 2, wc = wid & 3, fr = lane & 15, fq = lane >> 4;
    const int K = g.K, nt = K / BK;
    unsigned voffA[2], voffB[2];
#pragma unroll
    for (int i = 0; i < 2; ++i) { int R, C; stage_rc(tid * 16 + i * 8192, R, C); const int Rb = Epi::PERM ? ((R & ~31) + perm32(R & 31)) : R;
        voffA[i] = (unsigned)(R * g.lda + C) * 2u; voffB[i] = (unsigned)(Rb * g.ldb + C) * 2u; }
    const size_t kstep = (size_t)(BK * 2);
    const size_t hA = (size_t)HALF * g.lda * 2, hB = (size_t)HALF * g.ldb * 2;
    const size_t tA = 2 * hA, tB = 2 * hB;
    const unsigned ldsw = (unsigned)wid * 1024u;
    const int aoff = lds_byte(wr * 64 + fr, fq * 8), boff = lds_byte(wc * 32 + fr, fq * 8);
#define PG8_SA(b, h) (((b) * 2 + (h)) * HTB)
#define PG8_SB(b, h) ((4 + (b) * 2 + (h)) * HTB)
#define PG8_STAGE(bufoff, gbase, voff) do { _Pragma("unroll") for (int _i = 0; _i < 2; ++_i) \
        __builtin_amdgcn_global_load_lds((const unsigned*)((const char*)(gbase) + (voff)[_i]), (PG8_LAS unsigned*)(lds + (bufoff) + ldsw + _i * 8192), 16, 0, 0); } while (0)
#define PG8_LDA(dst, b, h) do { _Pragma("unroll") for (int m = 0; m < 4; ++m) _Pragma("unroll") for (int k = 0; k < 2; ++k) dst[m][k] = *(const PG8_LAS bf16x8*)(lds + PG8_SA(b, h) + aoff + m * 2048 + k * 1024); } while (0)
#define PG8_LDB(dst, b, h) do { _Pragma("unroll") for (int n = 0; n < 2; ++n) _Pragma("unroll") for (int k = 0; k < 2; ++k) dst[n][k] = *(const PG8_LAS bf16x8*)(lds + PG8_SB(b, h) + boff + n * 2048 + k * 1024); } while (0)
#define PG8_MMA(ai, bj, At, Bt) do { __builtin_amdgcn_s_setprio(1); _Pragma("unroll") for (int m = 0; m < 4; ++m) _Pragma("unroll") for (int n = 0; n < 2; ++n) _Pragma("unroll") for (int k = 0; k < 2; ++k) \
        acc[ai][bj][m][n] = __builtin_amdgcn_mfma_f32_16x16x32_bf16(Bt[n][k], At[m][k], acc[ai][bj][m][n], 0, 0, 0); __builtin_amdgcn_s_setprio(0); } while (0)
#define PG8_WAIT_V(n) asm volatile("s_waitcnt vmcnt(" #n ")" ::: "memory")
#define PG8_WAIT_L(n) asm volatile("s_waitcnt lgkmcnt(" #n ")" ::: "memory")
#define PG8_BAR __builtin_amdgcn_s_barrier()
#define PG8_SCHED __builtin_amdgcn_sched_barrier(0)
    Unit cur, nxt; int ui = 0;
    if (!S.next(0, cur)) return;
    f32x4 acc[2][2][4][2];
#pragma unroll
    for (int a = 0; a < 2; ++a)
#pragma unroll
        for (int b = 0; b < 2; ++b)
#pragma unroll
            for (int m = 0; m < 4; ++m)
#pragma unroll
                for (int n = 0; n < 2; ++n) acc[a][b][m][n] = (f32x4){0.f, 0.f, 0.f, 0.f};
    bf16x8 At[4][2], B0[2][2], B1[2][2];
    const char* cA = g.baseA(cur) + (size_t)cur.pm * tA; const char* cB = g.baseB(cur) + (size_t)cur.pn * tB;
    S.a_ready(cur);
    if constexpr (SP2) {
        PG8_STAGE(PG8_SB(0, 0), cB, voffB); PG8_STAGE(PG8_SB(0, 1), cB + hB, voffB); PG8_STAGE(PG8_SA(0, 0), cA, voffA); PG8_STAGE(PG8_SA(0, 1), cA + hA, voffA);
        if (wr == 1) PG8_BAR;
        PG8_WAIT_V(2); PG8_BAR;
        PG8_STAGE(PG8_SB(1, 0), cB + kstep, voffB); PG8_STAGE(PG8_SA(1, 0), cA + kstep, voffA); PG8_STAGE(PG8_SB(1, 1), cB + hB + kstep, voffB);
        PG8_WAIT_V(6); PG8_BAR;
    } else {
        PG8_STAGE(PG8_SB(0, 0), cB, voffB); PG8_STAGE(PG8_SA(0, 0), cA, voffA); PG8_STAGE(PG8_SB(0, 1), cB + hB, voffB); PG8_STAGE(PG8_SA(0, 1), cA + hA, voffA);
        if (wr == 1) PG8_BAR;
        PG8_WAIT_V(4); PG8_BAR;
        PG8_STAGE(PG8_SB(1, 0), cB + kstep, voffB); PG8_STAGE(PG8_SA(1, 0), cA + kstep, voffA); PG8_STAGE(PG8_SB(1, 1), cB + hB + kstep, voffB);
        PG8_WAIT_V(6); PG8_BAR;
    }
    for (;;) {
        const bool has_next = S.next(ui + 1, nxt);
        const char* nA = has_next ? g.baseA(nxt) + (size_t)nxt.pm * tA : cA; const char* nB = has_next ? g.baseB(nxt) + (size_t)nxt.pn * tB : cB;
        for (int t = 0; t < nt; t += 2) {
            const bool last = (t == nt - 2);
            const char* a1 = cA + (size_t)(t + 1) * kstep;
            const char* a2 = last ? nA : cA + (size_t)(t + 2) * kstep; const char* b2 = last ? nB : cB + (size_t)(t + 2) * kstep;
            const char* a3 = a2 + kstep; const char* b3 = b2 + kstep;
            if (last && has_next) S.a_ready(nxt);
            if constexpr (SP2) {
            PG8_LDB(B0, 0, 0); PG8_LDB(B1, 0, 1); PG8_SCHED; PG8_LDA(At, 0, 0); PG8_STAGE(PG8_SA(1, 1), a1 + hA, voffA);
            PG8_WAIT_V(8); PG8_WAIT_L(0); PG8_BAR; PG8_MMA(0, 0, At, B0); PG8_MMA(0, 1, At, B1); PG8_BAR; PG8_SCHED;
            PG8_LDA(At, 0, 1); PG8_STAGE(PG8_SB(0, 0), b2, voffB); PG8_STAGE(PG8_SB(0, 1), b2 + hB, voffB); PG8_STAGE(PG8_SA(0, 0), a2, voffA);
            PG8_WAIT_V(8); PG8_WAIT_L(0); PG8_BAR; PG8_MMA(1, 0, At, B0); PG8_MMA(1, 1, At, B1); PG8_BAR; PG8_SCHED;
            PG8_LDB(B0, 1, 0); PG8_LDB(B1, 1, 1); PG8_SCHED; PG8_LDA(At, 1, 0); PG8_STAGE(PG8_SA(0, 1), a2 + hA, voffA);
            PG8_WAIT_V(8); PG8_WAIT_L(0); PG8_BAR; PG8_MMA(0, 0, At, B0); PG8_MMA(0, 1, At, B1); PG8_BAR; PG8_SCHED;
            PG8_LDA(At, 1, 1); PG8_STAGE(PG8_SB(1, 0), b3, voffB); PG8_STAGE(PG8_SB(1, 1), b3 + hB, voffB); PG8_STAGE(PG8_SA(1, 0), a3, voffA);
            PG8_WAIT_V(8); PG8_WAIT_L(0); PG8_BAR; PG8_MMA(1, 0, At, B0); PG8_MMA(1, 1, At, B1); PG8_BAR; PG8_SCHED;
            } else {
            PG8_LDB(B0, 0, 0); PG8_SCHED; PG8_LDA(At, 0, 0); PG8_STAGE(PG8_SA(1, 1), a1 + hA, voffA);
            PG8_WAIT_L(8); PG8_BAR; PG8_WAIT_L(0); PG8_MMA(0, 0, At, B0); PG8_BAR; PG8_SCHED;
            PG8_LDB(B1, 0, 1); PG8_STAGE(PG8_SB(0, 0), b2, voffB);
            PG8_BAR; PG8_WAIT_L(0); PG8_MMA(0, 1, At, B1); PG8_BAR;
            PG8_LDA(At, 0, 1); PG8_STAGE(PG8_SA(0, 0), a2, voffA);
            PG8_BAR; PG8_WAIT_L(0); PG8_MMA(1, 0, At, B0); PG8_BAR; PG8_SCHED;
            PG8_STAGE(PG8_SB(0, 1), b2 + hB, voffB);
            PG8_WAIT_V(6); PG8_BAR; PG8_MMA(1, 1, At, B1); PG8_BAR;
            PG8_LDB(B0, 1, 0); PG8_SCHED; PG8_LDA(At, 1, 0); PG8_STAGE(PG8_SA(0, 1), a2 + hA, voffA);
            PG8_WAIT_L(8); PG8_BAR; PG8_WAIT_L(0); PG8_MMA(0, 0, At, B0); PG8_BAR; PG8_SCHED;
            PG8_LDB(B1, 1, 1); PG8_STAGE(PG8_SB(1, 0), b3, voffB);
            PG8_BAR; PG8_WAIT_L(0); PG8_MMA(0, 1, At, B1); PG8_BAR;
            PG8_LDA(At, 1, 1); PG8_STAGE(PG8_SA(1, 0), a3, voffA);
            PG8_BAR; PG8_WAIT_L(0); PG8_MMA(1, 0, At, B0); PG8_BAR; PG8_SCHED;
            PG8_STAGE(PG8_SB(1, 1), b3 + hB, voffB);
            PG8_WAIT_V(6); PG8_BAR; PG8_MMA(1, 1, At, B1); PG8_BAR;
            }
        }
        if constexpr (ALIGN_EPI) { if (wr == 0) PG8_BAR; }
        if constexpr (!Epi::AFTER_DRAIN) { E(acc, cur, wr, wc, fr, fq); S.done(cur); }
        if (!has_next) break;
#pragma unroll
        for (int a = 0; a < 2; ++a)
#pragma unroll
            for (int b = 0; b < 2; ++b)
#pragma unroll
                for (int m = 0; m < 4; ++m)
#pragma unroll
                    for (int n = 0; n < 2; ++n) acc[a][b][m][n] = (f32x4){0.f, 0.f, 0.f, 0.f};
        cur = nxt; cA = nA; cB = nB; ++ui;
        if constexpr (ALIGN_EPI) { if (wr == 1) PG8_BAR; }
    }
    PG8_WAIT_V(0);
    if constexpr (!ALIGN_EPI) { if (wr == 0) PG8_BAR; }
    PG8_BAR;
    if constexpr (Epi::AFTER_DRAIN) { E.fused(acc, cur, wr, wc, fr, fq, lds, wid, lane); S.done(cur); }
#undef PG8_SA
#undef PG8_SB
#undef PG8_STAGE
#undef PG8_LDA
#undef PG8_LDB
#undef PG8_MMA
#undef PG8_WAIT_V
#undef PG8_WAIT_L
#undef PG8_BAR
#undef PG8_SCHED
}
}

constexpr int NWAVES = 8;
constexpr int DM = 2048, BATCH = 8, SEQ = 2048, CTXL = 256, DFF = 5632, NMOD = 9 * DM;
constexpr int MLAT = BATCH * SEQ, MCTX = BATCH * CTXL, MALL = MLAT + MCTX;
constexpr float EPS = 1e-6f;

constexpr size_t MiB = 1u << 20;
constexpr size_t WS_CTL = 0, CTL_ZERO_BYTES = 1 * MiB;
constexpr size_t WS_WIN = 1 * MiB;
constexpr size_t WS_WOUT = 177 * MiB;
constexpr size_t WS_WRIN = 265 * MiB;
constexpr size_t WS_WROUT = 281 * MiB;
constexpr size_t WS_WFOU = 289 * MiB;
constexpr size_t WS_GW = 297 * MiB;
constexpr size_t WS_T2 = 299 * MiB;
constexpr size_t WS_TW = 315 * MiB;
constexpr size_t WS_MODP = 316 * MiB;
constexpr size_t WS_MOD = 322 * MiB;
constexpr size_t WS_XS = 324 * MiB;
constexpr size_t WS_H = 468 * MiB;
constexpr size_t WS_ACT = 540 * MiB;
constexpr size_t WS_Y = 738 * MiB;
constexpr size_t WS_END = 882 * MiB;
constexpr size_t WIN_ELEMS = (size_t)2 * DFF * DM, WOUT_ELEMS = (size_t)DM * DFF;
constexpr int CW_BAR = 4096;

constexpr int RING_OFF = 0, RING_BYTES = 131072;
constexpr int LDSCTL_OFF = RING_BYTES, MISC_OFF = LDSCTL_OFF + 320;
constexpr int LDS_BYTES = 147456;

#define GAS __attribute__((address_space(1)))
#define LAS __attribute__((address_space(3)))
typedef unsigned short bf16;
typedef unsigned v4u __attribute__((ext_vector_type(4)));
typedef unsigned v2u __attribute__((ext_vector_type(2)));
typedef float f32x4 __attribute__((ext_vector_type(4)));
typedef short bf16x8 __attribute__((ext_vector_type(8)));
typedef GAS unsigned gu32;
#define RLX_AGENT __ATOMIC_RELAXED, __HIP_MEMORY_SCOPE_AGENT
#define LDS_WAIT() asm volatile("s_waitcnt lgkmcnt(0)" ::: "memory")
#define VM_WAIT() asm volatile("s_waitcnt vmcnt(0)" ::: "memory")
__device__ __forceinline__ unsigned f2bf(float f) { unsigned u = __builtin_bit_cast(unsigned, f); return (u + 0x7fffu + ((u >> 16) & 1u)) >> 16; }
__device__ __forceinline__ unsigned pk2(float lo, float hi) { return f2bf(lo) | (f2bf(hi) << 16); }
__device__ __forceinline__ float bf_lo(unsigned w) { return __uint_as_float(w << 16); }
__device__ __forceinline__ float bf_hi(unsigned w) { return __uint_as_float(w & 0xffff0000u); }

#define XB_TMO      128
#define XB_XCNT(j)  (256  + 64 * (j))
#define XB_XSUB(j)  (1280 + 64 * (j))
#define XB_XGEN(j)  (2304 + 64 * (j))
#define XB_TOP      3328
#define XB_TOPGEN   3392
#define XCD_BAR_WORDS 3456
#define XB_SPIN_CAP (1u << 18)

__device__ __forceinline__ unsigned xb_ld(unsigned* p)              { return __hip_atomic_load(p, __ATOMIC_RELAXED, __HIP_MEMORY_SCOPE_AGENT); }
__device__ __forceinline__ unsigned xb_add(unsigned* p, unsigned v) { return __hip_atomic_fetch_add(p, v, __ATOMIC_RELAXED, __HIP_MEMORY_SCOPE_AGENT); }
__device__ __forceinline__ unsigned xb_xcc_id() { return (unsigned)__builtin_amdgcn_s_getreg((3 << 11) | 20) & 0xFu; }
#define XB_SPIN(cond, bar) do { unsigned _sp = 0; while (cond) { __builtin_amdgcn_s_sleep(1); \
    if ((++_sp & 255u) == 0u) { if (xb_ld(&(bar)[XB_TMO])) break; if (_sp > XB_SPIN_CAP) { atomicAdd(&(bar)[XB_TMO], 1u); break; } } } } while (0)

struct XcdBarrier {
    unsigned* bar; unsigned x;
    volatile LAS unsigned* st;
};
__device__ __forceinline__ XcdBarrier xcd_barrier_post(unsigned* bar, volatile LAS unsigned* st) {
    XcdBarrier b; b.bar = bar; b.x = xb_xcc_id(); b.st = st;
    if (threadIdx.x == 0) (void)xb_add(&bar[XB_XCNT(b.x)], 1u);
    return b;
}
__device__ __forceinline__ void xcd_barrier_complete(unsigned* bar, unsigned x, unsigned& nloc, unsigned& nx) {
    const unsigned G = gridDim.x * gridDim.y * gridDim.z;
    unsigned sum, cnt, mine, sp = 0u;
    for (;;) {
        sum = 0u; cnt = 0u; mine = 0u;
#pragma unroll
        for (unsigned j = 0; j < 16; ++j) { const unsigned c = xb_ld(&bar[XB_XCNT(j)]); sum += c; cnt += (c > 0u) ? 1u : 0u; mine = (j == x) ? c : mine; }
        if (sum == G) break;
        __builtin_amdgcn_s_sleep(1);
        if ((++sp & 255u) == 0u) { if (xb_ld(&bar[XB_TMO])) break; if (sp > XB_SPIN_CAP) { atomicAdd(&bar[XB_TMO], 1u); break; } }
    }
    nloc = mine > 0u ? mine : 1u; nx = cnt > 0u ? cnt : 1u;
}
__device__ __forceinline__ void xcd_barrier(const XcdBarrier& b) {
    asm volatile("s_waitcnt vmcnt(0)" ::: "memory");
    __syncthreads();
    if (threadIdx.x == 0) {
        unsigned* bar = b.bar;
        __builtin_amdgcn_s_waitcnt(0);
        unsigned nloc = b.st[0], nx = b.st[1];
        if (nloc == 0u) { xcd_barrier_complete(bar, b.x, nloc, nx); b.st[0] = nloc; b.st[1] = nx; }
        const unsigned old = xb_add(&bar[XB_XSUB(b.x)], 1u);
        const unsigned gen = old / nloc;
        if (old + 1u == (gen + 1u) * nloc) {
            __builtin_amdgcn_fence(__ATOMIC_RELEASE, "agent");
            asm volatile("s_waitcnt vmcnt(0)" ::: "memory");
            const unsigned og = xb_add(&bar[XB_TOP], 1u);
            const unsigned tg = og / nx;
            if (og + 1u == (tg + 1u) * nx) xb_add(&bar[XB_TOPGEN], 1u);
            else XB_SPIN(xb_ld(&bar[XB_TOPGEN]) == tg, bar);
            __builtin_amdgcn_fence(__ATOMIC_ACQUIRE, "agent");
            xb_add(&bar[XB_XGEN(b.x)], 1u);
            asm volatile("s_waitcnt vmcnt(0)" ::: "memory");
        } else {
            XB_SPIN(xb_ld(&bar[XB_XGEN(b.x)]) == gen, bar);
            __builtin_amdgcn_fence(__ATOMIC_ACQUIRE, "agent");
            asm volatile("s_waitcnt vmcnt(0)" ::: "memory");
        }
    }
    __syncthreads();
}

struct Frame {
    LAS unsigned char* lds;
    volatile LAS unsigned* MISC;
    gu32* ctl;
    int tid, lane, wave, G;
};
__device__ __forceinline__ float wave_sum(float v) {
#pragma unroll
    for (int o = 1; o < 64; o <<= 1) v += __shfl_xor(v, o);
    return v;
}

__device__ __forceinline__ void p0_adaln(Frame& F, const float* c, const float* cctx, const float* mod_w, float* MODP) {
    LAS float* S = (LAS float*)F.lds;
    LAS float* RED = S + 9 * 512;
    for (int it = blockIdx.x; it < 2 * 4 * 72; it += F.G) {
        const int l = it / 288, rem = it % 288, kb = rem / 72, cg = rem % 72;
        __syncthreads();
        for (int i = F.tid; i < 9 * 512; i += NWAVES * 64) { const int r = i >> 9, k = i & 511; const float cv = (r < 8) ? c[r * DM + kb * 512 + k] : cctx[kb * 512 + k]; S[i] = cv / (1.0f + __expf(-cv)); }
        __syncthreads();
        f32x4 acc[9];
#pragma unroll
        for (int r = 0; r < 9; ++r) acc[r] = (f32x4){0.f, 0.f, 0.f, 0.f};
        const float* W = mod_w + ((size_t)l * DM + kb * 512 + F.wave * 64) * NMOD + cg * 256 + F.lane * 4;
        for (int k = 0; k < 64; k += 4) {
            const f32x4 w0 = *(const f32x4*)(W + (size_t)(k + 0) * NMOD), w1 = *(const f32x4*)(W + (size_t)(k + 1) * NMOD), w2 = *(const f32x4*)(W + (size_t)(k + 2) * NMOD), w3 = *(const f32x4*)(W + (size_t)(k + 3) * NMOD);
#pragma unroll
            for (int r = 0; r < 9; ++r) { const f32x4 s4 = *(const LAS f32x4*)(S + r * 512 + F.wave * 64 + k); acc[r] += w0 * s4.x + w1 * s4.y + w2 * s4.z + w3 * s4.w; }
        }
#pragma unroll
        for (int r = 0; r < 9; ++r) *(LAS f32x4*)(RED + (F.wave * 9 + r) * 256 + F.lane * 4) = acc[r];
        __syncthreads();
        for (int i = F.tid; i < 9 * 256; i += NWAVES * 64) { const int r = i >> 8, cc = i & 255; float s = 0.f;
#pragma unroll
            for (int w = 0; w < 8; ++w) s += RED[(w * 9 + r) * 256 + cc];
            MODP[((size_t)(l * 4 + kb) * 9 + r) * NMOD + cg * 256 + cc] = s; }
    }
    __syncthreads();
}
__device__ __forceinline__ void p0_adaln_reduce(Frame& F, const float* MODP, const float* mod_b, float* MOD) {
    for (int i = blockIdx.x * (NWAVES * 64) + F.tid; i < 2 * 9 * NMOD; i += F.G * NWAVES * 64) {
        const int l = i / (9 * NMOD), rn = i % (9 * NMOD), n = rn % NMOD;
        float s = mod_b[l * NMOD + n];
#pragma unroll
        for (int kb = 0; kb < 4; ++kb) s += MODP[(size_t)(l * 4 + kb) * 9 * NMOD + rn];
        MOD[i] = s;
    }
}

__device__ __forceinline__ void p0_transpose_item(const float* W, int N, bf16* WT, int ldt, int dst_row0, LAS float* scr, int k0, int n0, int lane) {
#pragma unroll 8
    for (int i = 0; i < 32; ++i) { const int kk = 2 * i + (lane >> 5); scr[kk * 33 + (lane & 31)] = W[(size_t)(k0 + kk) * N + n0 + (lane & 31)]; }
    LDS_WAIT(); asm volatile("" ::: "memory");
    const int c = lane & 7;
#pragma unroll
    for (int j = 0; j < 4; ++j) { const int n = (lane >> 3) + 8 * j; const LAS float* s = scr + (8 * c) * 33 + n;
        v4u o; o.x = pk2(s[0 * 33], s[1 * 33]); o.y = pk2(s[2 * 33], s[3 * 33]); o.z = pk2(s[4 * 33], s[5 * 33]); o.w = pk2(s[6 * 33], s[7 * 33]);
        *(GAS v4u*)(WT + (size_t)(dst_row0 + n) * ldt + k0 + 8 * c) = o; }
    LDS_WAIT(); asm volatile("" ::: "memory");
}
struct WeightPtrs { const float *ffn_in, *ffn_out, *rec_in, *rec_out, *fou_out, *gate_w; bf16 *WinT, *WoutT, *WrinT, *WroutT, *WfouT, *GW; };
__device__ __forceinline__ void p0_weights(Frame& F, const WeightPtrs& P) {
    LAS float* scr = (LAS float*)(F.lds + RING_OFF + F.wave * 16384);
    const int gw = blockIdx.x * NWAVES + F.wave, NGW = F.G * NWAVES;
    constexpr int I_IN = (DM / 64) * (2 * DFF / 32), I_OUT = (DFF / 64) * (DM / 32), I_RIN = (DM / 64) * (2 * DM / 32), I_SQ = (DM / 64) * (DM / 32), I_G = 2 * 4;
    constexpr int NITEMS = 4 * I_IN + 4 * I_OUT + I_RIN + 2 * I_SQ + 64 * I_G;
    for (int it = gw; it < NITEMS; it += NGW) {
        int r = it;
        if (r < 4 * I_IN) { const int mi = r / I_IN, q = r % I_IN, nblk = 2 * DFF / 32, kb = q / nblk, nb = q % nblk, n0 = 32 * nb;
            const int s = n0 / DFF, f = n0 % DFF, drow = 256 * (f / 128) + 128 * s + (f % 128);
            p0_transpose_item(P.ffn_in + (size_t)mi * DM * 2 * DFF, 2 * DFF, P.WinT + (size_t)mi * WIN_ELEMS, DM, drow, scr, 64 * kb, n0, F.lane); continue; }
        r -= 4 * I_IN;
        if (r < 4 * I_OUT) { const int mi = r / I_OUT, q = r % I_OUT, nblk = DM / 32, kb = q / nblk, nb = q % nblk;
            p0_transpose_item(P.ffn_out + (size_t)mi * DFF * DM, DM, P.WoutT + (size_t)mi * WOUT_ELEMS, DFF, 32 * nb, scr, 64 * kb, 32 * nb, F.lane); continue; }
        r -= 4 * I_OUT;
        if (r < I_RIN) { const int nblk = 2 * DM / 32, kb = r / nblk, nb = r % nblk;
            p0_transpose_item(P.rec_in, 2 * DM, P.WrinT, DM, 32 * nb, scr, 64 * kb, 32 * nb, F.lane); continue; }
        r -= I_RIN;
        if (r < 2 * I_SQ) { const int mi = r / I_SQ, q = r % I_SQ, nblk = DM / 32, kb = q / nblk, nb = q % nblk;
            p0_transpose_item(mi ? P.fou_out : P.rec_out, DM, mi ? P.WfouT : P.WroutT, DM, 32 * nb, scr, 64 * kb, 32 * nb, F.lane); continue; }
        r -= 2 * I_SQ;
        { const int mi = r / I_G, q = r % I_G, kb = q / 4, nb = q % 4;
            p0_transpose_item(P.gate_w + (size_t)mi * 128 * 128, 128, P.GW + (size_t)mi * 128 * 128, 128, 32 * nb, scr, 64 * kb, 32 * nb, F.lane); }
    }
}
__device__ __forceinline__ void p0_twiddles(Frame& F, bf16* T2, bf16* TW) {
    const int gt = blockIdx.x * (NWAVES * 64) + F.tid, NGT = F.G * NWAVES * 64;
    for (int i = gt; i < 2048 * 4096 / 8; i += NGT) {
        const int k1 = i >> 9, col = (i & 511) * 8, cs = col >> 11, n0 = col & 2047;
        float v[8];
#pragma unroll
        for (int e = 0; e < 8; ++e) { const int m = (k1 * (n0 + e)) & 2047; const float ang = (float)m * (1.0f / 1024.0f); v[e] = cs ? -sinpif(ang) : cospif(ang); }
        v4u o; o.x = pk2(v[0], v[1]); o.y = pk2(v[2], v[3]); o.z = pk2(v[4], v[5]); o.w = pk2(v[6], v[7]);
        *(GAS v4u*)(T2 + (size_t)i * 8) = o;
    }
    for (int i = gt; i < 512 * 256 / 8; i += NGT) {
        const int row = i >> 5, c0 = (i & 31) * 8, cs = row >> 8, k2 = row & 255;
        float v[8];
#pragma unroll
        for (int e = 0; e < 8; ++e) { const int m = (k2 * (c0 + e)) & 255; const float ang = (float)m * (1.0f / 128.0f); v[e] = cs ? sinpif(ang) : cospif(ang); }
        v4u o; o.x = pk2(v[0], v[1]); o.y = pk2(v[2], v[3]); o.z = pk2(v[4], v[5]); o.w = pk2(v[6], v[7]);
        *(GAS v4u*)(TW + (size_t)i * 8) = o;
    }
}

template <bool RES, bool HOUT, bool CTX>
__device__ __forceinline__ void thin_phase(Frame& F, const float* xl, const float* xc, const float* Y, float* ol, float* oc, bf16* H,
                                           const float* gpost, const float* modr, int gate_ch, float coef, const float* gpre, const float* modn, int sh_ch, int sc_ch) {
    LAS float* VA = (LAS float*)F.lds;
    LAS float* VB = VA + 2 * DM;
    LAS float* VC = VB + 2 * DM;
    for (int vb = blockIdx.x; vb < 256; vb += F.G) {
        const int b = vb >> 5;
        __syncthreads();
        for (int i = F.tid; i < DM; i += NWAVES * 64) {
            if (RES) { const float gp = coef * gpost[i]; VA[i] = gp * modr[(b * 9 + gate_ch) * DM + i]; if (CTX) VA[DM + i] = gp * modr[(8 * 9 + gate_ch) * DM + i]; }
            if (HOUT) { const float gq = gpre[i]; VB[i] = gq * (1.0f + modn[(b * 9 + sc_ch) * DM + i]); VC[i] = modn[(b * 9 + sh_ch) * DM + i];
                if (CTX) { VB[DM + i] = gq * (1.0f + modn[(8 * 9 + sc_ch) * DM + i]); VC[DM + i] = modn[(8 * 9 + sh_ch) * DM + i]; } }
        }
        __syncthreads();
        for (int rr = F.wave; rr < (CTX ? 72 : 64); rr += NWAVES) {
            const bool isctx = rr >= 64; const int lrow = isctx ? vb * 8 + (rr - 64) : vb * 64 + rr, row = isctx ? MLAT + lrow : lrow, vo = isctx ? DM / 4 : 0;
            const f32x4* xr = (const f32x4*)((isctx ? xc : xl) + (size_t)lrow * DM) + F.lane;
            f32x4 xv[8];
#pragma unroll
            for (int j = 0; j < 8; ++j) xv[j] = xr[64 * j];
            if (RES) {
                const f32x4* yr = (const f32x4*)(Y + (size_t)row * DM) + F.lane; f32x4 yv[8]; float ss = 0.f;
#pragma unroll
                for (int j = 0; j < 8; ++j) { yv[j] = yr[64 * j]; ss += (yv[j].x * yv[j].x + yv[j].y * yv[j].y) + (yv[j].z * yv[j].z + yv[j].w * yv[j].w); }
                const float rstd = rsqrtf(wave_sum(ss) * (1.0f / DM) + EPS);
                f32x4* orow = (f32x4*)((isctx ? oc : ol) + (size_t)lrow * DM) + F.lane;
#pragma unroll
                for (int j = 0; j < 8; ++j) { const f32x4 va = ((const LAS f32x4*)VA)[vo + 64 * j + F.lane]; xv[j] = xv[j] + va * yv[j] * rstd; orow[64 * j] = xv[j]; }
            }
            if (HOUT) {
                float ss = 0.f;
#pragma unroll
                for (int j = 0; j < 8; ++j) ss += (xv[j].x * xv[j].x + xv[j].y * xv[j].y) + (xv[j].z * xv[j].z + xv[j].w * xv[j].w);
                const float rstd = rsqrtf(wave_sum(ss) * (1.0f / DM) + EPS);
                GAS v2u* hrow = (GAS v2u*)(H + (size_t)row * DM) + F.lane;
#pragma unroll
                for (int j = 0; j < 8; ++j) { const f32x4 vb4 = ((const LAS f32x4*)VB)[vo + 64 * j + F.lane], vc4 = ((const LAS f32x4*)VC)[vo + 64 * j + F.lane];
                    const f32x4 h = xv[j] * rstd * vb4 + vc4; v2u o; o.x = pk2(h.x, h.y); o.y = pk2(h.z, h.w); hrow[64 * j] = o; }
            }
        }
    }
    __syncthreads();
}

constexpr int VROW = 272;
__device__ __forceinline__ int rho_of(int t) { return 16 * ((t >> 2) & 3) + 4 * (t >> 4) + (t & 3); }
__device__ __forceinline__ void scan_phase(Frame& F, const bf16* V, bf16* G, float* YP, const bf16* GW, const float* conv_w, const float* conv_b, const float* gate_b, const float* lam) {
    const int hb = F.wave >> 2, wv = F.wave & 3, th = F.tid & 255, lane = F.lane, jj = lane & 15, g = lane >> 4, d = hb;
    LAS unsigned char* Vraw = F.lds + hb * 40960;
    LAS unsigned char* VCb = Vraw + 18432;
    for (int u = blockIdx.x; u < 256; u += F.G) {
        const int b = u >> 5, q = u & 31, hd = q >> 1, half = q & 1, ch0 = hd * 128, jl = half * 64 + wv * 16 + jj, cj = ch0 + jl;
        const float ba = gate_b[(d * 2 + 0) * DM + cj], bx = gate_b[(d * 2 + 1) * DM + cj];
        const float lm = lam[d * DM + cj];
        const float sp = fmaxf(-lm, 0.f) + log1pf(__expf(-fabsf(lm)));
        const float cneg2 = -8.0f * sp * 1.4426950408889634f;
        bf16x8 Bf[2][4];
#pragma unroll
        for (int gt = 0; gt < 2; ++gt)
#pragma unroll
            for (int s = 0; s < 4; ++s) Bf[gt][s] = *(const bf16x8*)(GW + ((size_t)((d * 2 + gt) * 16 + hd) * 128 + jl) * 128 + 32 * s + 8 * g);
        const int col16 = th & 15, trow = th >> 4;
        float cw[4][8], cb[8];
#pragma unroll
        for (int e = 0; e < 8; ++e) { cb[e] = conv_b[ch0 + 8 * col16 + e];
#pragma unroll
            for (int k = 0; k < 4; ++k) cw[k][e] = conv_w[k * DM + ch0 + 8 * col16 + e]; }
        float carry = 0.f;
        v4u vpre[4], vhalo = (v4u){0u, 0u, 0u, 0u};
#define SCAN_CHUNK(k, isctx, cidx, rowbase) const bool isctx = (k) < 4; const int cidx = isctx ? (d ? 3 - (k) : (k)) : (d ? 35 - (k) : (k) - 4); const int rowbase = isctx ? MLAT + b * CTXL + 64 * cidx : b * SEQ + 64 * cidx;
#define SCAN_PREFETCH(k) do { SCAN_CHUNK(k, pc_, pi_, pr_) \
            _Pragma("unroll") for (int it = 0; it < 4; ++it) vpre[it] = *(const v4u*)(V + (size_t)(pr_ + trow + 16 * it) * DM + ch0 + 8 * col16); \
            vhalo = (v4u){0u, 0u, 0u, 0u}; \
            if (pc_ && th < 48) { const int toff = trow == 0 ? -2 : (trow == 1 ? -1 : 64), tok = 64 * pi_ + toff; \
                if (tok >= 0 && tok < CTXL) vhalo = *(const v4u*)(V + (size_t)(pr_ + toff) * DM + ch0 + 8 * col16); } } while (0)
        SCAN_PREFETCH(0);
        for (int k = 0; k < 36; ++k) {
            SCAN_CHUNK(k, isctx, cidx, rowbase)
            const bool fin = !isctx && (d ? cidx <= 15 : cidx >= 16);
#pragma unroll
            for (int it = 0; it < 4; ++it) *(LAS v4u*)(Vraw + (trow + 16 * it + 2) * VROW + col16 * 16) = vpre[it];
            if (th < 48) *(LAS v4u*)(Vraw + (trow == 0 ? 0 : (trow == 1 ? 1 : 66)) * VROW + col16 * 16) = vhalo;
            if (k + 1 < 36) SCAN_PREFETCH(k + 1);
            __syncthreads();
            float yp[16]; unsigned gg[16];
            if (fin) {
#pragma unroll
                for (int i = 0; i < 16; ++i) { const size_t off = (size_t)(rowbase + 16 * g + i) * DM + cj; yp[i] = YP[off]; gg[i] = G[off]; }
            }
#pragma unroll
            for (int it = 0; it < 4; ++it) { const int t = trow + 16 * it; float o[8];
#pragma unroll
                for (int e = 0; e < 8; ++e) o[e] = cb[e];
#pragma unroll
                for (int kk = 0; kk < 4; ++kk) { const v4u r = *(const LAS v4u*)(Vraw + (t + kk) * VROW + col16 * 16);
                    o[0] += cw[kk][0] * bf_lo(r.x); o[1] += cw[kk][1] * bf_hi(r.x); o[2] += cw[kk][2] * bf_lo(r.y); o[3] += cw[kk][3] * bf_hi(r.y);
                    o[4] += cw[kk][4] * bf_lo(r.z); o[5] += cw[kk][5] * bf_hi(r.z); o[6] += cw[kk][6] * bf_lo(r.w); o[7] += cw[kk][7] * bf_hi(r.w); }
                v4u w; w.x = pk2(o[0], o[1]); w.y = pk2(o[2], o[3]); w.z = pk2(o[4], o[5]); w.w = pk2(o[6], o[7]);
                *(LAS v4u*)(VCb + rho_of(t) * VROW + col16 * 16) = w; }
            __syncthreads();
            f32x4 Cr[4], Ci[4];
#pragma unroll
            for (int m = 0; m < 4; ++m) { Cr[m] = (f32x4){0.f, 0.f, 0.f, 0.f}; Ci[m] = (f32x4){0.f, 0.f, 0.f, 0.f};
#pragma unroll
                for (int s = 0; s < 4; ++s) { const bf16x8 a = *(const LAS bf16x8*)(VCb + (16 * m + jj) * VROW + (32 * s + 8 * g) * 2);
                    Cr[m] = __builtin_amdgcn_mfma_f32_16x16x32_bf16(a, Bf[0][s], Cr[m], 0, 0, 0);
                    Ci[m] = __builtin_amdgcn_mfma_f32_16x16x32_bf16(a, Bf[1][s], Ci[m], 0, 0, 0); } }
            float av[16], bv[16];
#pragma unroll
            for (int m = 0; m < 4; ++m)
#pragma unroll
                for (int r = 0; r < 4; ++r) { const int i = 4 * m + r;
                    const float vc = __uint_as_float((unsigned)(*(const LAS unsigned short*)(VCb + (16 * m + 4 * g + r) * VROW + jl * 2)) << 16);
                    const float rg = pg8::sigmoid_f(Cr[m][r] + ba), ig = pg8::sigmoid_f(Ci[m][r] + bx);
                    const float a = __builtin_amdgcn_exp2f(rg * cneg2);
                    av[i] = a; bv[i] = __builtin_sqrtf(fmaxf(1.0f - a * a, 0.f)) * ig * vc; }
            float P = 1.f, Hh = 0.f;
            if (d == 0) {
#pragma unroll
                for (int i = 0; i < 16; ++i) { Hh = av[i] * Hh + bv[i]; P *= av[i]; }
            } else {
#pragma unroll
                for (int i = 15; i >= 0; --i) { Hh = av[i] * Hh + bv[i]; P *= av[i]; }
            }
            float Pk[4], Hk[4];
#pragma unroll
            for (int kk = 0; kk < 4; ++kk) { Pk[kk] = __shfl(P, jj + 16 * kk); Hk[kk] = __shfl(Hh, jj + 16 * kk); }
            float s = carry, cin = 0.f;
            if (d == 0) {
#pragma unroll
                for (int kk = 0; kk < 4; ++kk) { if (kk == g) cin = s; s = Pk[kk] * s + Hk[kk]; }
            } else {
#pragma unroll
                for (int kk = 3; kk >= 0; --kk) { if (kk == g) cin = s; s = Pk[kk] * s + Hk[kk]; }
            }
            carry = s;
            if (!isctx) {
                float h = cin;
                if (d == 0) {
#pragma unroll
                    for (int i = 0; i < 16; ++i) { h = av[i] * h + bv[i]; av[i] = h; }
                } else {
#pragma unroll
                    for (int i = 15; i >= 0; --i) { h = av[i] * h + bv[i]; av[i] = h; }
                }
                if (fin) {
#pragma unroll
                    for (int i = 0; i < 16; ++i) { const size_t off = (size_t)(rowbase + 16 * g + i) * DM + cj; G[off] = (bf16)f2bf(__uint_as_float(gg[i] << 16) * (av[i] + yp[i])); }
                } else {
#pragma unroll
                    for (int i = 0; i < 16; ++i) { const size_t off = (size_t)(rowbase + 16 * g + i) * DM + cj; YP[off] = av[i]; }
                }
            }
            VM_WAIT();
        }
        __syncthreads();
#undef SCAN_CHUNK
#undef SCAN_PREFETCH
    }
}

struct Args { const float* in[17]; float* out; unsigned char* ws; };
__global__ void __launch_bounds__(NWAVES * 64, 2) fwd_kernel(Args args) {
    extern __shared__ __attribute__((aligned(16))) unsigned char lds[];
    Frame F;
    F.lds = (LAS unsigned char*)lds;
    F.MISC = (volatile LAS unsigned*)(F.lds + MISC_OFF);
    F.tid = threadIdx.x; F.lane = F.tid & 63; F.wave = __builtin_amdgcn_readfirstlane(F.tid >> 6);
    F.G = gridDim.x;
    unsigned char* ws = args.ws;
    F.ctl = (gu32*)(ws + WS_CTL);
    for (int u = F.tid; u < (LDS_BYTES - LDSCTL_OFF) / 4; u += NWAVES * 64) ((LAS unsigned*)(F.lds + LDSCTL_OFF))[u] = 0u;
    __syncthreads();
    XcdBarrier bar = xcd_barrier_post((unsigned*)(F.ctl + CW_BAR), F.MISC + 8);
#define GRID_BAR() xcd_barrier(bar)

    const float* x_in = args.in[0]; const float* c_in = args.in[1]; const float* ctx_in = args.in[2]; const float* cctx_in = args.in[3];
    const float* mod_w = args.in[4]; const float* mod_b = args.in[5]; const float* norm_g = args.in[6];
    bf16* WinT = (bf16*)(ws + WS_WIN); bf16* WoutT = (bf16*)(ws + WS_WOUT); bf16* WrinT = (bf16*)(ws + WS_WRIN); bf16* WroutT = (bf16*)(ws + WS_WROUT); bf16* WfouT = (bf16*)(ws + WS_WFOU);
    bf16* GW = (bf16*)(ws + WS_GW); bf16* T2 = (bf16*)(ws + WS_T2); bf16* TW = (bf16*)(ws + WS_TW);
    float* MODP = (float*)(ws + WS_MODP); float* MOD = (float*)(ws + WS_MOD);
    float* XS = (float*)(ws + WS_XS); bf16* H = (bf16*)(ws + WS_H); bf16* ACT = (bf16*)(ws + WS_ACT); float* Y = (float*)(ws + WS_Y);
    bf16* Gb = ACT; bf16* Vb = ACT + (size_t)MALL * DM;
    bf16* ZT = ACT; bf16* Fb = ACT + (size_t)BATCH * DM * 4096;
    float* XSc = XS + (size_t)MLAT * DM;
    const float* MOD0 = MOD; const float* MOD1 = MOD + 9 * NMOD;
#define NG(l, i) (norm_g + ((l) * 6 + (i)) * DM)
    const int cid = (int)blockIdx.x;

    p0_adaln(F, c_in, cctx_in, mod_w, MODP);
    { WeightPtrs P{args.in[7], args.in[8], args.in[9], args.in[15], args.in[16], args.in[12], WinT, WoutT, WrinT, WroutT, WfouT, GW}; p0_weights(F, P); }
    p0_twiddles(F, T2, TW);
    GRID_BAR();
    p0_adaln_reduce(F, MODP, mod_b, MOD);
    GRID_BAR();
    thin_phase<false, true, true>(F, x_in, ctx_in, nullptr, nullptr, nullptr, H, nullptr, nullptr, 0, 0.f, NG(0, 0), MOD0, 0, 1);
    GRID_BAR();
    { pg8::Gemm g{H, WinT, DM, DM, DM, 1, 0, 0, 0, 0}; pg8::BatchOrder S; S.init(MALL, 2 * DFF, 1, F.G, cid); pg8::EpiSwiGLU E{ACT, DFF};
      pg8::gemm_phase<pg8::EpiSwiGLU, pg8::BatchOrder, true, true>(F.lds + RING_OFF, g, S, E); }
    GRID_BAR();
    { pg8::Gemm g{ACT, WoutT, DFF, DFF, DFF, 1, 0, 0, 0, 0}; pg8::BatchOrder S; S.init(MALL, DM, 1, F.G, cid); pg8::EpiF32 E{Y, DM};
      pg8::gemm_phase<pg8::EpiF32, pg8::BatchOrder, true, true>(F.lds + RING_OFF, g, S, E); }
    GRID_BAR();
    thin_phase<true, true, true>(F, x_in, ctx_in, Y, XS, XSc, H, NG(0, 1), MOD0, 2, 0.5f, NG(0, 2), MOD0, 3, 4);
    GRID_BAR();
    { pg8::Gemm g{H, WrinT, DM, DM, DM, 1, 0, 0, 0, 0}; pg8::BatchOrder S; S.init(MALL, 2 * DM, 1, F.G, cid); pg8::EpiGV E{Gb, Vb};
      pg8::gemm_phase<pg8::EpiGV, pg8::BatchOrder, true, true>(F.lds + RING_OFF, g, S, E); }
    GRID_BAR();
    scan_phase(F, Vb, Gb, Y, GW, args.in[10], args.in[11], args.in[13], args.in[14]);
    GRID_BAR();
    { pg8::Gemm g{Gb, WroutT, DM, DM, DM, 1, 0, 0, 0, 0}; pg8::BatchOrder S; S.init(MLAT, DM, 1, F.G, cid); pg8::EpiF32 E{Y, DM};
      pg8::gemm_phase<pg8::EpiF32, pg8::BatchOrder, true, true>(F.lds + RING_OFF, g, S, E); }
    GRID_BAR();
    thin_phase<true, true, false>(F, XS, nullptr, Y, XS, nullptr, H, NG(0, 3), MOD0, 5, 1.0f, NG(0, 4), MOD0, 6, 7);
    GRID_BAR();
    { pg8::Gemm g{H, WinT + WIN_ELEMS, DM, DM, DM, 1, 0, 0, 0, 0}; pg8::BatchOrder S; S.init(MLAT, 2 * DFF, 1, F.G, cid); pg8::EpiSwiGLU E{ACT, DFF};
      pg8::gemm_phase<pg8::EpiSwiGLU, pg8::BatchOrder, true, true>(F.lds + RING_OFF, g, S, E); }
    GRID_BAR();
    { pg8::Gemm g{ACT, WoutT + WOUT_ELEMS, DFF, DFF, DFF, 1, 0, 0, 0, 0}; pg8::BatchOrder S; S.init(MLAT, DM, 1, F.G, cid); pg8::EpiF32 E{Y, DM};
      pg8::gemm_phase<pg8::EpiF32, pg8::BatchOrder, true, true>(F.lds + RING_OFF, g, S, E); }
    GRID_BAR();
    thin_phase<true, true, false>(F, XS, nullptr, Y, XS, nullptr, H, NG(0, 5), MOD0, 8, 0.5f, NG(1, 0), MOD1, 0, 1);
    GRID_BAR();
    { pg8::Gemm g{H, WinT + 2 * WIN_ELEMS, DM, DM, DM, 1, 0, 0, 0, 0}; pg8::BatchOrder S; S.init(MLAT, 2 * DFF, 1, F.G, cid); pg8::EpiSwiGLU E{ACT, DFF};
      pg8::gemm_phase<pg8::EpiSwiGLU, pg8::BatchOrder, true, true>(F.lds + RING_OFF, g, S, E); }
    GRID_BAR();
    { pg8::Gemm g{ACT, WoutT + 2 * WOUT_ELEMS, DFF, DFF, DFF, 1, 0, 0, 0, 0}; pg8::BatchOrder S; S.init(MLAT, DM, 1, F.G, cid); pg8::EpiF32 E{Y, DM};
      pg8::gemm_phase<pg8::EpiF32, pg8::BatchOrder, true, true>(F.lds + RING_OFF, g, S, E); }
    GRID_BAR();
    thin_phase<true, true, false>(F, XS, nullptr, Y, XS, nullptr, H, NG(1, 1), MOD1, 2, 0.5f, NG(1, 2), MOD1, 3, 4);
    GRID_BAR();
    { pg8::Gemm g{TW, H, 256, DM, 256, 8, 0, 0, (long)SEQ * DM * 2, 256 * 2}; pg8::BatchOrder S; S.init(512, SEQ, 64, F.G, cid); pg8::EpiZT E{ZT};
      pg8::gemm_phase<pg8::EpiZT, pg8::BatchOrder, true, true>(F.lds + RING_OFF, g, S, E); }
    GRID_BAR();
    { pg8::Gemm g{T2, ZT, 4096, 4096, 4096, 1, 0, 0, (long)DM * 4096 * 2, 0}; pg8::BatchOrder S; S.init(SEQ, DM, 8, F.G, cid); pg8::EpiBf16Z E{Fb, DM, SEQ, 0.02209708691207961f};
      pg8::gemm_phase<pg8::EpiBf16Z, pg8::BatchOrder, true, true>(F.lds + RING_OFF, g, S, E); }
    GRID_BAR();
    { pg8::Gemm g{Fb, WfouT, DM, DM, DM, 1, 0, 0, 0, 0}; pg8::BatchOrder S; S.init(MLAT, DM, 1, F.G, cid); pg8::EpiF32 E{Y, DM};
      pg8::gemm_phase<pg8::EpiF32, pg8::BatchOrder, true, true>(F.lds + RING_OFF, g, S, E); }
    GRID_BAR();
    thin_phase<true, true, false>(F, XS, nullptr, Y, XS, nullptr, H, NG(1, 3), MOD1, 5, 1.0f, NG(1, 4), MOD1, 6, 7);
    GRID_BAR();
    { pg8::Gemm g{H, WinT + 3 * WIN_ELEMS, DM, DM, DM, 1, 0, 0, 0, 0}; pg8::BatchOrder S; S.init(MLAT, 2 * DFF, 1, F.G, cid); pg8::EpiSwiGLU E{ACT, DFF};
      pg8::gemm_phase<pg8::EpiSwiGLU, pg8::BatchOrder, true, true>(F.lds + RING_OFF, g, S, E); }
    GRID_BAR();
    { pg8::Gemm g{ACT, WoutT + 3 * WOUT_ELEMS, DFF, DFF, DFF, 1, 0, 0, 0, 0}; pg8::BatchOrder S; S.init(MLAT, DM, 1, F.G, cid); pg8::EpiF32 E{Y, DM};
      pg8::gemm_phase<pg8::EpiF32, pg8::BatchOrder, true, true>(F.lds + RING_OFF, g, S, E); }
    GRID_BAR();
    thin_phase<true, false, false>(F, XS, nullptr, Y, args.out, nullptr, nullptr, NG(1, 5), MOD1, 8, 0.5f, nullptr, nullptr, 0, 0);
#undef NG
#undef GRID_BAR
}

extern "C" void kernel_launch(void* const* d_in, const int* in_sizes, int n_in, void* d_out, int out_size, void* d_ws, size_t ws_size, hipStream_t stream) {
    static int grid = 0;
    if (grid == 0) {
        if (n_in != 17 || in_sizes[0] != MLAT * DM || out_size != MLAT * DM || ws_size < WS_END) {
            fprintf(stderr, "kernel_launch: unexpected problem (n_in %d, in0 %d, out %d, ws %zu; need ws >= %zu); nothing launched\n", n_in, n_in > 0 ? in_sizes[0] : -1, out_size, ws_size, (size_t)WS_END); grid = -1; return; }
        int dev = 0, cus = 0, per_cu = 0;
        if (hipGetDevice(&dev) != hipSuccess || hipDeviceGetAttribute(&cus, hipDeviceAttributeMultiprocessorCount, dev) != hipSuccess) { fprintf(stderr, "kernel_launch: device query failed\n"); grid = -1; return; }
        if (hipFuncSetAttribute((const void*)fwd_kernel, hipFuncAttributeMaxDynamicSharedMemorySize, LDS_BYTES) != hipSuccess) { fprintf(stderr, "kernel_launch: hipFuncSetAttribute failed\n"); grid = -1; return; }
        if (hipOccupancyMaxActiveBlocksPerMultiprocessor(&per_cu, (const void*)fwd_kernel, NWAVES * 64, LDS_BYTES) != hipSuccess || per_cu < 1)
            fprintf(stderr, "kernel_launch: note: occupancy query reports %d workgroups per CU\n", per_cu);
        (void)hipGetLastError();
        grid = cus < 256 ? cus : 256;
    }
    if (grid < 0) return;
    if (hipMemsetAsync((char*)d_ws + WS_CTL, 0, CTL_ZERO_BYTES, stream) != hipSuccess) { fprintf(stderr, "kernel_launch: hipMemsetAsync failed\n"); return; }
    Args a{};
    for (int i = 0; i < 17; ++i) a.in[i] = (const float*)d_in[i];
    a.out = (float*)d_out; a.ws = (unsigned char*)d_ws;
    hipLaunchKernelGGL(fwd_kernel, dim3(grid), dim3(NWAVES * 64), LDS_BYTES, stream, a);
    const hipError_t le = hipPeekAtLastError();
    if (le != hipSuccess) fprintf(stderr, "kernel_launch: launch failed: %s\n", hipGetErrorName(le));
}
```

```cpp
#include <hip/hip_runtime.h>
#include <cstdio>
#include <cstdint>

namespace pg8 {
#define PG8_LAS __attribute__((address_space(3)))
typedef unsigned short bf16_t;
typedef short bf16x8 __attribute__((ext_vector_type(8)));
typedef float f32x4 __attribute__((ext_vector_type(4)));
typedef unsigned u32x4 __attribute__((ext_vector_type(4)));
typedef int i32x4 __attribute__((ext_vector_type(4)));
constexpr int BM = 256, BK = 64, HALF = 128, HTB = HALF * BK * 2  , STAGE_BYTES = 8 * HTB, NXCD = 8, WGM = 8;

__host__ __device__ __forceinline__ int lds_byte(int r, int c) { const int st = (r >> 4) * 2 + (c >> 5), rr = r & 15, cc = c & 31, ob = rr * 64 + cc * 2; return st * 1024 + (ob ^ (((ob >> 9) & 1) << 5)); }
__host__ __device__ __forceinline__ void stage_rc(int b, int& R, int& C) { const int st = b / 1024, sb = b % 1024, swz = sb ^ (((sb >> 9) & 1) << 5); R = (st >> 1) * 16 + swz / 64; C = (st & 1) * 32 + (swz % 64) / 2; }
__host__ __device__ __forceinline__ int perm32(int rho) { const int n = rho >> 4, i = rho & 15; return 8 * (i >> 2) + 4 * n + (i & 3); }

struct Unit { int pm, pn, z; };
struct Gemm { const bf16_t* A; const bf16_t* Bt; int lda, ldb, K, zdiv; long a_s1, a_s0, b_s1, b_s0; long a_kstep = 0, a_tile = 0, b_kstep = 0, b_tile = 0;
    __device__ __forceinline__ const char* baseA(const Unit& u) const { return (const char*)A + (long)(u.z / zdiv) * a_s1 + (long)(u.z % zdiv) * a_s0; }
    __device__ __forceinline__ const char* baseB(const Unit& u) const { return (const char*)Bt + (long)(u.z / zdiv) * b_s1 + (long)(u.z % zdiv) * b_s0; } };

struct BatchOrder {
    int nM, nN, per, nwg, G, c;
    __host__ __device__ void init(int M, int N, int nz, int G_, int c_) { nM = M / BM; nN = N / BM; per = nM * nN; nwg = per * nz; G = G_; c = c_; }
    __host__ __device__ bool next(int i, Unit& u) const {
        const long L = (long)i * G + c; if (L >= nwg) return false;
        int wgid = (int)L; { const int q = nwg / NXCD, r = nwg % NXCD, xcd = wgid % NXCD, off = wgid / NXCD; wgid = (xcd < r ? xcd * (q + 1) : r * (q + 1) + (xcd - r) * q) + off; }
        u.z = wgid / per; const int w = wgid % per;
        const int nig = WGM * nN, gid = w / nig, fm = gid * WGM, gsz = (nM - fm) < WGM ? (nM - fm) : WGM;
        u.pm = fm + ((w % nig) % gsz); u.pn = (w % nig) / gsz; return true;
    }
    __device__ __forceinline__ void a_ready(const Unit&) const {}
    __device__ __forceinline__ void done(const Unit&) const {}
};

struct ChOrder {
    int nwg, G, c;
    __host__ __device__ void init(int nz, int G_, int c_) { nwg = nz * 8; G = G_; c = c_; }
    __host__ __device__ bool next(int i, Unit& u) const {
        const long L = (long)i * G + c; if (L >= nwg) return false;
        int wgid = (int)L; { const int q = nwg / NXCD, r = nwg % NXCD, xcd = wgid % NXCD, off = wgid / NXCD; wgid = (xcd < r ? xcd * (q + 1) : r * (q + 1) + (xcd - r) * q) + off; }
        u.z = wgid >> 3; u.pn = wgid & 7; u.pm = u.pn >> 2; return true;
    }
    __device__ __forceinline__ void a_ready(const Unit&) const {}
    __device__ __forceinline__ void done(const Unit&) const {}
};

__device__ __forceinline__ unsigned cvt_pk_bf16(float lo, float hi) { unsigned r; asm volatile("v_cvt_pk_bf16_f32 %0, %1, %2" : "=v"(r) : "v"(lo), "v"(hi)); return r; }
__device__ __forceinline__ float sigmoid_f(float x) { return __builtin_amdgcn_rcpf(1.0f + __builtin_amdgcn_exp2f(-1.4426950408889634f * x)); }
__device__ __forceinline__ float gelu_tanh_f(float x) { return x * sigmoid_f(1.5957691216057308f * (x + 0.044715f * x * x * x)); }

struct EpiF32 {
    static constexpr bool PERM = false, AFTER_DRAIN = false;
    float* C; int ldc; long zs;
    __device__ __forceinline__ void operator()(const f32x4 (&acc)[2][2][4][2], const Unit& u, int wr, int wc, int fr, int fq) const {
        const int row0 = u.pm * BM + wr * 64 + fr, col0 = u.pn * BM + wc * 32 + 4 * fq;
#pragma unroll
        for (int ai = 0; ai < 2; ++ai)
#pragma unroll
            for (int m = 0; m < 4; ++m) { float* rowp = C + (size_t)u.z * zs + (size_t)(row0 + ai * HALF + m * 16) * ldc + col0;
#pragma unroll
                for (int bj = 0; bj < 2; ++bj)
#pragma unroll
                    for (int n = 0; n < 2; ++n) *(f32x4*)(rowp + bj * HALF + n * 16) = acc[ai][bj][m][n]; }
    }
};
struct EpiSwiGLU {
    static constexpr bool PERM = true, AFTER_DRAIN = false;
    bf16_t* O; int ldc;
    __device__ __forceinline__ void operator()(const f32x4 (&acc)[2][2][4][2], const Unit& u, int wr, int wc, int fr, int fq) const {
        const int row0 = u.pm * BM + wr * 64 + fr, col0 = u.pn * HALF + wc * 32 + 8 * fq;
#pragma unroll
        for (int ai = 0; ai < 2; ++ai)
#pragma unroll
            for (int m = 0; m < 4; ++m) { bf16_t* rowp = O + (size_t)(row0 + ai * HALF + m * 16) * ldc + col0;
                float o[8];
#pragma unroll
                for (int n = 0; n < 2; ++n)
#pragma unroll
                    for (int j = 0; j < 4; ++j) { const float gv = acc[ai][0][m][n][j], uv = acc[ai][1][m][n][j]; o[4 * n + j] = gv * sigmoid_f(gv) * uv; }
                u32x4 w; w.x = cvt_pk_bf16(o[0], o[1]); w.y = cvt_pk_bf16(o[2], o[3]); w.z = cvt_pk_bf16(o[4], o[5]); w.w = cvt_pk_bf16(o[6], o[7]);
                *(u32x4*)rowp = w; }
    }
};
struct EpiSwiGLU8 {
    static constexpr bool PERM = true, AFTER_DRAIN = false;
    bf16_t* O; int ldc; const float* sa; const float* sw;
    typedef float f32x2 __attribute__((ext_vector_type(2)));
    __device__ __forceinline__ void operator()(const f32x4 (&acc)[2][2][4][2], const Unit& u, int wr, int wc, int fr, int fq) const {
        const int row0 = u.pm * BM + wr * 64 + fr, col0 = u.pn * HALF + wc * 32 + 8 * fq, wrow0 = u.pn * BM + wc * 32 + 8 * fq;
        f32x4 sg[2], su[2]; float sr[2][4];
#pragma unroll
        for (int n = 0; n < 2; ++n) { sg[n] = *(const f32x4*)(sw + wrow0 + 4 * n); su[n] = *(const f32x4*)(sw + wrow0 + HALF + 4 * n); }
#pragma unroll
        for (int ai = 0; ai < 2; ++ai)
#pragma unroll
            for (int m = 0; m < 4; ++m) sr[ai][m] = sa[row0 + ai * HALF + m * 16];
        f32x2 sgn[4], sgu[4];
#pragma unroll
        for (int p = 0; p < 4; ++p) { const int n = p >> 1, h = 2 * (p & 1); const f32x2 g2 = (f32x2){sg[n][h], sg[n][h + 1]}, u2 = (f32x2){su[n][h], su[n][h + 1]};
            sgn[p] = g2 * -1.4426950408889634f; sgu[p] = g2 * u2; }
#pragma unroll
        for (int ai = 0; ai < 2; ++ai)
#pragma unroll
            for (int m = 0; m < 4; ++m) { const int r = row0 + ai * HALF + m * 16; const float s = sr[ai][m], s2 = s * s; bf16_t* rowp = O + ((((size_t)(r >> 8) * (5632 / 64) + (col0 >> 6)) * 256 + (r & 255)) << 6) + (col0 & 63);
                unsigned wv[4];
#pragma unroll
                for (int p = 0; p < 4; ++p) { const int n = p >> 1, h = 2 * (p & 1);
                    const float g0 = acc[ai][0][m][n][h], g1 = acc[ai][0][m][n][h + 1], u0 = acc[ai][1][m][n][h], u1 = acc[ai][1][m][n][h + 1];
                    const f32x2 gf = (f32x2){(float)__float_as_int(g0), (float)__float_as_int(g1)}, uf = (f32x2){(float)__float_as_int(u0), (float)__float_as_int(u1)};
                    const f32x2 arg = gf * (sgn[p] * s);
                    const f32x2 d = (f32x2){__builtin_amdgcn_exp2f(arg.x), __builtin_amdgcn_exp2f(arg.y)} + 1.0f;
                    const f32x2 rc = (f32x2){__builtin_amdgcn_rcpf(d.x), __builtin_amdgcn_rcpf(d.y)};
                    const f32x2 o = (gf * uf) * ((sgu[p] * s2) * rc);
                    wv[p] = cvt_pk_bf16(o.x, o.y); }
                u32x4 w; w.x = wv[0]; w.y = wv[1]; w.z = wv[2]; w.w = wv[3];
                *(u32x4*)rowp = w; }
    }
};
struct EpiGV {
    static constexpr bool PERM = true, AFTER_DRAIN = false;
    bf16_t* G; bf16_t* V; const float* cw; const float* cb;
    __device__ __forceinline__ void operator()(const f32x4 (&acc)[2][2][4][2], const Unit& u, int wr, int wc, int fr, int fq) const {
        const bool isg = u.pn < 8; bf16_t* base = isg ? G : V;
        const int row0 = u.pm * BM + wr * 64 + fr, col0 = (isg ? u.pn : u.pn - 8) * BM + wc * 32 + 8 * fq;
        if (isg) {
#pragma unroll
            for (int ai = 0; ai < 2; ++ai)
#pragma unroll
                for (int m = 0; m < 4; ++m) { bf16_t* rowp = base + (size_t)(row0 + ai * HALF + m * 16) * 2048 + col0;
#pragma unroll
                    for (int bj = 0; bj < 2; ++bj) { f32x4 v0 = acc[ai][bj][m][0], v1 = acc[ai][bj][m][1];
#pragma unroll
                        for (int j = 0; j < 4; ++j) { v0[j] = gelu_tanh_f(v0[j]); v1[j] = gelu_tanh_f(v1[j]); }
                        u32x4 w; w.x = cvt_pk_bf16(v0[0], v0[1]); w.y = cvt_pk_bf16(v0[2], v0[3]); w.z = cvt_pk_bf16(v1[0], v1[1]); w.w = cvt_pk_bf16(v1[2], v1[3]);
                        *(u32x4*)(rowp + bj * HALF) = w; } }
        } else {
#pragma unroll
            for (int bj = 0; bj < 2; ++bj) {
                f32x4 w[4][2], bb[2];
#pragma unroll
                for (int n = 0; n < 2; ++n) { bb[n] = *(const f32x4*)(cb + col0 + bj * HALF + 4 * n);
#pragma unroll
                    for (int k = 0; k < 4; ++k) w[k][n] = *(const f32x4*)(cw + k * 2048 + col0 + bj * HALF + 4 * n); }
#pragma unroll
                for (int ai = 0; ai < 2; ++ai) {
                    f32x4 o[4][2];
#pragma unroll
                    for (int n = 0; n < 2; ++n)
#pragma unroll
                        for (int j = 0; j < 4; ++j) {
                            float r1[4], r2[4], f1[4];
#pragma unroll
                            for (int m = 0; m < 4; ++m) { const int xi = __float_as_int(acc[ai][bj][m][n][j]);
                                r1[m] = __int_as_float(__builtin_amdgcn_update_dpp(0, xi, 0x121, 0xf, 0xf, false));
                                r2[m] = __int_as_float(__builtin_amdgcn_update_dpp(0, xi, 0x122, 0xf, 0xf, false));
                                f1[m] = __int_as_float(__builtin_amdgcn_update_dpp(0, xi, 0x12f, 0xf, 0xf, false)); }
#pragma unroll
                            for (int m = 0; m < 4; ++m) {
                                const float xm1 = fr >= 1 ? r1[m] : (m > 0 ? r1[m > 0 ? m - 1 : 0] : 0.f);
                                const float xm2 = fr >= 2 ? r2[m] : (m > 0 ? r2[m > 0 ? m - 1 : 0] : 0.f);
                                const float xp1 = fr <= 14 ? f1[m] : (m < 3 ? f1[m < 3 ? m + 1 : 3] : 0.f);
                                o[m][n][j] = bb[n][j] + w[0][n][j] * xm2 + w[1][n][j] * xm1 + w[2][n][j] * acc[ai][bj][m][n][j] + w[3][n][j] * xp1; }
                        }
#pragma unroll
                    for (int m = 0; m < 4; ++m) { bf16_t* rowp = base + (size_t)(row0 + ai * HALF + m * 16) * 2048 + col0 + bj * HALF;
                        u32x4 wv; wv.x = cvt_pk_bf16(o[m][0][0], o[m][0][1]); wv.y = cvt_pk_bf16(o[m][0][2], o[m][0][3]); wv.z = cvt_pk_bf16(o[m][1][0], o[m][1][1]); wv.w = cvt_pk_bf16(o[m][1][2], o[m][1][3]);
                        *(u32x4*)rowp = wv; }
                }
            }
        }
    }
};
struct EpiBf16Z {
    static constexpr bool PERM = true, AFTER_DRAIN = false;
    bf16_t* O; int ldc; int roff_z; float scale;
    __device__ __forceinline__ void operator()(const f32x4 (&acc)[2][2][4][2], const Unit& u, int wr, int wc, int fr, int fq) const {
        const int row0 = u.z * roff_z + u.pm * BM + wr * 64 + fr, col0 = u.pn * BM + wc * 32 + 8 * fq;
#pragma unroll
        for (int ai = 0; ai < 2; ++ai)
#pragma unroll
            for (int m = 0; m < 4; ++m) { bf16_t* rowp = O + (size_t)(row0 + ai * HALF + m * 16) * ldc + col0;
#pragma unroll
                for (int bj = 0; bj < 2; ++bj) { const f32x4 v0 = acc[ai][bj][m][0] * scale, v1 = acc[ai][bj][m][1] * scale;
                    u32x4 w; w.x = cvt_pk_bf16(v0[0], v0[1]); w.y = cvt_pk_bf16(v0[2], v0[3]); w.z = cvt_pk_bf16(v1[0], v1[1]); w.w = cvt_pk_bf16(v1[2], v1[3]);
                    *(u32x4*)(rowp + bj * HALF) = w; } }
    }
};
struct EpiQ {
    static constexpr bool PERM = true, AFTER_DRAIN = false;
    const bf16_t* PB; bf16_t* Fo; const float* En; float scale;
    __device__ __forceinline__ void operator()(const f32x4 (&acc)[2][2][4][2], const Unit& u, int wr, int wc, int fr, int fq) const {
        const int k0 = u.pm * BM + wr * 64 + fr, col0 = u.pn * BM + wc * 32 + 8 * fq;
        float se[2][8];
        { const float sg = (fr & 1) ? -1.0f : 1.0f;
#pragma unroll
          for (int bj = 0; bj < 2; ++bj) { const f32x4 e0 = *(const f32x4*)(En + (size_t)u.z * 2048 + col0 + bj * HALF), e1 = *(const f32x4*)(En + (size_t)u.z * 2048 + col0 + bj * HALF + 4);
              se[bj][0] = sg * e0[0]; se[bj][1] = sg * e0[1]; se[bj][2] = sg * e0[2]; se[bj][3] = sg * e0[3]; se[bj][4] = sg * e1[0]; se[bj][5] = sg * e1[1]; se[bj][6] = sg * e1[2]; se[bj][7] = sg * e1[3]; } }
#pragma unroll
        for (int ai = 0; ai < 2; ++ai) {
            u32x4 pwv[4][2];
#pragma unroll
            for (int m = 0; m < 4; ++m) { const bf16_t* prow = PB + ((size_t)u.z * 1024 + (k0 + ai * HALF + m * 16)) * 2048 + col0;
                pwv[m][0] = *(const u32x4*)prow; pwv[m][1] = *(const u32x4*)(prow + HALF); }
#pragma unroll
            for (int m = 0; m < 4; ++m) { const int k = k0 + ai * HALF + m * 16;
                bf16_t* frow = Fo + ((size_t)u.z * 2048 + k) * 2048 + col0; bf16_t* mrow = Fo + ((size_t)u.z * 2048 + (2048 - k)) * 2048 + col0;
#pragma unroll
                for (int bj = 0; bj < 2; ++bj) { const u32x4 pw = pwv[m][bj]; const f32x4 q0 = acc[ai][bj][m][0], q1 = acc[ai][bj][m][1];
                    const float p[8] = {__uint_as_float(pw.x << 16) + se[bj][0], __uint_as_float(pw.x & 0xffff0000u) + se[bj][1], __uint_as_float(pw.y << 16) + se[bj][2], __uint_as_float(pw.y & 0xffff0000u) + se[bj][3],
                                        __uint_as_float(pw.z << 16) + se[bj][4], __uint_as_float(pw.z & 0xffff0000u) + se[bj][5], __uint_as_float(pw.w << 16) + se[bj][6], __uint_as_float(pw.w & 0xffff0000u) + se[bj][7]};
                    const float q[8] = {q0[0], q0[1], q0[2], q0[3], q1[0], q1[1], q1[2], q1[3]};
                    u32x4 wp, wm;
                    wp.x = cvt_pk_bf16((p[0] + q[0]) * scale, (p[1] + q[1]) * scale); wp.y = cvt_pk_bf16((p[2] + q[2]) * scale, (p[3] + q[3]) * scale);
                    wp.z = cvt_pk_bf16((p[4] + q[4]) * scale, (p[5] + q[5]) * scale); wp.w = cvt_pk_bf16((p[6] + q[6]) * scale, (p[7] + q[7]) * scale);
                    wm.x = cvt_pk_bf16((p[0] - q[0]) * scale, (p[1] - q[1]) * scale); wm.y = cvt_pk_bf16((p[2] - q[2]) * scale, (p[3] - q[3]) * scale);
                    wm.z = cvt_pk_bf16((p[4] - q[4]) * scale, (p[5] - q[5]) * scale); wm.w = cvt_pk_bf16((p[6] - q[6]) * scale, (p[7] - q[7]) * scale);
                    *(u32x4*)(frow + bj * HALF) = wp;
                    if (k > 0) *(u32x4*)(mrow + bj * HALF) = wm; } } }
    }
};
struct EpiZT {
    static constexpr bool PERM = true, AFTER_DRAIN = false;
    bf16_t* ZT;
    __device__ __forceinline__ void operator()(const f32x4 (&acc)[2][2][4][2], const Unit& u, int wr, int wc, int fr, int fq) const {
        const int b = u.z >> 3, g = u.z & 7;
        bf16_t* base = ZT + ((size_t)b * 2048 + (size_t)g * 256) * 2048;
        const int row0 = wr * 64 + fr, col0 = u.pn * BM + wc * 32 + 8 * fq;
#pragma unroll
        for (int ai = 0; ai < 2; ++ai)
#pragma unroll
            for (int m = 0; m < 4; ++m) { bf16_t* rowp = base + (size_t)(row0 + ai * HALF + m * 16) * 2048 + col0;
#pragma unroll
                for (int bj = 0; bj < 2; ++bj) { const f32x4 v0 = acc[ai][bj][m][0] * 0.0625f, v1 = acc[ai][bj][m][1] * 0.0625f;
                    u32x4 w; w.x = cvt_pk_bf16(v0[0], v0[1]); w.y = cvt_pk_bf16(v0[2], v0[3]); w.z = cvt_pk_bf16(v1[0], v1[1]); w.w = cvt_pk_bf16(v1[2], v1[3]);
                    *(u32x4*)(rowp + bj * HALF) = w; } }
    }
};

template <class Epi, class Sched, bool ALIGN_EPI = false, bool SP2 = false, bool I8 = false>
__device__ __forceinline__ void gemm_phase(PG8_LAS unsigned char* lds, const Gemm g, const Sched& S, const Epi& E, const int wave) {
    int tid_; asm volatile("v_mbcnt_lo_u32_b32 %0, -1, 0\n\tv_mbcnt_hi_u32_b32 %0, -1, %0" : "=v"(tid_)); tid_ += wave * 64;
    const int tid = tid_, wid = wave, lane = tid & 63, wr = wid >> 2, wc = wid & 3, fr = lane & 15, fq = lane >> 4;
    const int K = g.K, nt = K / BK;
    unsigned voffA[2], voffB[2];
#pragma unroll
    for (int i = 0; i < 2; ++i) { int R, C; stage_rc(tid * 16 + i * 8192, R, C); const int Rb = Epi::PERM ? ((R & ~31) + perm32(R & 31)) : R;
        voffA[i] = (unsigned)(R * g.lda + C) * 2u; voffB[i] = (unsigned)(Rb * g.ldb + C) * 2u; }
    const size_t kstep = (size_t)(BK * 2);
    const size_t kstepA = g.a_kstep ? (size_t)g.a_kstep : kstep, kstepB = g.b_kstep ? (size_t)g.b_kstep : kstep;
    const size_t hA = (size_t)HALF * g.lda * 2, hB = (size_t)HALF * g.ldb * 2;
    const size_t tA = g.a_tile ? (size_t)g.a_tile : 2 * hA, tB = g.b_tile ? (size_t)g.b_tile : 2 * hB;
    const unsigned ldsw = (unsigned)wid * 1024u;
    const int aoff = lds_byte(wr * 64 + fr, fq * 8), boff = lds_byte(wc * 32 + fr, fq * 8);
#define PG8_SA(b, h) (((b) * 2 + (h)) * HTB)
#define PG8_SB(b, h) ((4 + (b) * 2 + (h)) * HTB)
#define PG8_STAGE(bufoff, gbase, voff) do { _Pragma("unroll") for (int _i = 0; _i < 2; ++_i) \
        __builtin_amdgcn_global_load_lds((const unsigned*)((const char*)(gbase) + (voff)[_i]), (PG8_LAS unsigned*)(lds + (bufoff) + ldsw + _i * 8192), 16, 0, 0); } while (0)
#define PG8_LDA(dst, b, h) do { _Pragma("unroll") for (int m = 0; m < 4; ++m) _Pragma("unroll") for (int k = 0; k < 2; ++k) dst[m][k] = *(const PG8_LAS bf16x8*)(lds + PG8_SA(b, h) + aoff + m * 2048 + k * 1024); } while (0)
#define PG8_LDB(dst, b, h) do { _Pragma("unroll") for (int n = 0; n < 2; ++n) _Pragma("unroll") for (int k = 0; k < 2; ++k) dst[n][k] = *(const PG8_LAS bf16x8*)(lds + PG8_SB(b, h) + boff + n * 2048 + k * 1024); } while (0)
#define PG8_MMA(ai, bj, At, Bt) do { __builtin_amdgcn_s_setprio(1); _Pragma("unroll") for (int m = 0; m < 4; ++m) _Pragma("unroll") for (int n = 0; n < 2; ++n) _Pragma("unroll") for (int k = 0; k < 2; ++k) \
        { if constexpr (I8) acc[ai][bj][m][n] = __builtin_bit_cast(f32x4, __builtin_amdgcn_mfma_i32_16x16x64_i8(__builtin_bit_cast(i32x4, Bt[n][k]), __builtin_bit_cast(i32x4, At[m][k]), __builtin_bit_cast(i32x4, acc[ai][bj][m][n]), 0, 0, 0)); \
          else acc[ai][bj][m][n] = __builtin_amdgcn_mfma_f32_16x16x32_bf16(Bt[n][k], At[m][k], acc[ai][bj][m][n], 0, 0, 0); } __builtin_amdgcn_s_setprio(0); } while (0)
#define PG8_WAIT_V(n) asm volatile("s_waitcnt vmcnt(" #n ")" ::: "memory")
#define PG8_WAIT_L(n) asm volatile("s_waitcnt lgkmcnt(" #n ")" ::: "memory")
#define PG8_BAR __builtin_amdgcn_s_barrier()
#define PG8_SCHED __builtin_amdgcn_sched_barrier(0)
    Unit cur, nxt; int ui = 0;
    if (!S.next(0, cur)) return;
    f32x4 acc[2][2][4][2];
#pragma unroll
    for (int a = 0; a < 2; ++a)
#pragma unroll
        for (int b = 0; b < 2; ++b)
#pragma unroll
            for (int m = 0; m < 4; ++m)
#pragma unroll
                for (int n = 0; n < 2; ++n) acc[a][b][m][n] = (f32x4){0.f, 0.f, 0.f, 0.f};
    bf16x8 At[4][2], B0[2][2], B1[2][2];
    const char* cA = g.baseA(cur) + (size_t)cur.pm * tA; const char* cB = g.baseB(cur) + (size_t)cur.pn * tB;
    S.a_ready(cur);
    if constexpr (SP2) {
        PG8_STAGE(PG8_SB(0, 0), cB, voffB); PG8_STAGE(PG8_SB(0, 1), cB + hB, voffB); PG8_STAGE(PG8_SA(0, 0), cA, voffA); PG8_STAGE(PG8_SA(0, 1), cA + hA, voffA);
        if (wr == 1) PG8_BAR;
        PG8_WAIT_V(2); PG8_BAR;
        PG8_STAGE(PG8_SB(1, 0), cB + kstepB, voffB); PG8_STAGE(PG8_SA(1, 0), cA + kstepA, voffA); PG8_STAGE(PG8_SB(1, 1), cB + hB + kstepB, voffB);
        PG8_WAIT_V(6); PG8_BAR;
    } else {
        PG8_STAGE(PG8_SB(0, 0), cB, voffB); PG8_STAGE(PG8_SA(0, 0), cA, voffA); PG8_STAGE(PG8_SB(0, 1), cB + hB, voffB); PG8_STAGE(PG8_SA(0, 1), cA + hA, voffA);
        if (wr == 1) PG8_BAR;
        PG8_WAIT_V(4); PG8_BAR;
        PG8_STAGE(PG8_SB(1, 0), cB + kstepB, voffB); PG8_STAGE(PG8_SA(1, 0), cA + kstepA, voffA); PG8_STAGE(PG8_SB(1, 1), cB + hB + kstepB, voffB);
        PG8_WAIT_V(6); PG8_BAR;
    }
    for (;;) {
        const bool has_next = S.next(ui + 1, nxt);
        const char* nA = has_next ? g.baseA(nxt) + (size_t)nxt.pm * tA : cA; const char* nB = has_next ? g.baseB(nxt) + (size_t)nxt.pn * tB : cB;
        for (int t = 0; t < nt; t += 2) {
            const bool last = (t == nt - 2);
            const char* a1 = cA + (size_t)(t + 1) * kstepA;
            const char* a2 = last ? nA : cA + (size_t)(t + 2) * kstepA; const char* b2 = last ? nB : cB + (size_t)(t + 2) * kstepB;
            const char* a3 = a2 + kstepA; const char* b3 = b2 + kstepB;
            if (last && has_next) S.a_ready(nxt);
            if constexpr (SP2) {
            PG8_LDB(B0, 0, 0); PG8_LDB(B1, 0, 1); PG8_SCHED; PG8_LDA(At, 0, 0); PG8_STAGE(PG8_SA(1, 1), a1 + hA, voffA);
            PG8_WAIT_V(8); PG8_WAIT_L(0); PG8_BAR; PG8_MMA(0, 0, At, B0); PG8_MMA(0, 1, At, B1); PG8_BAR; PG8_SCHED;
            PG8_LDA(At, 0, 1); PG8_STAGE(PG8_SB(0, 0), b2, voffB); PG8_STAGE(PG8_SB(0, 1), b2 + hB, voffB); PG8_STAGE(PG8_SA(0, 0), a2, voffA);
            PG8_WAIT_V(8); PG8_WAIT_L(0); PG8_BAR; PG8_MMA(1, 0, At, B0); PG8_MMA(1, 1, At, B1); PG8_BAR; PG8_SCHED;
            PG8_LDB(B0, 1, 0); PG8_LDB(B1, 1, 1); PG8_SCHED; PG8_LDA(At, 1, 0); PG8_STAGE(PG8_SA(0, 1), a2 + hA, voffA);
            PG8_WAIT_V(8); PG8_WAIT_L(0); PG8_BAR; PG8_MMA(0, 0, At, B0); PG8_MMA(0, 1, At, B1); PG8_BAR; PG8_SCHED;
            PG8_LDA(At, 1, 1); PG8_STAGE(PG8_SB(1, 0), b3, voffB); PG8_STAGE(PG8_SB(1, 1), b3 + hB, voffB); PG8_STAGE(PG8_SA(1, 0), a3, voffA);
            PG8_WAIT_V(8); PG8_WAIT_L(0); PG8_BAR; PG8_MMA(1, 0, At, B0); PG8_MMA(1, 1, At, B1); PG8_BAR; PG8_SCHED;
            } else {
            PG8_LDB(B0, 0, 0); PG8_SCHED; PG8_LDA(At, 0, 0); PG8_STAGE(PG8_SA(1, 1), a1 + hA, voffA);
            PG8_WAIT_L(8); PG8_BAR; PG8_WAIT_L(0); PG8_MMA(0, 0, At, B0); PG8_BAR; PG8_SCHED;
            PG8_LDB(B1, 0, 1); PG8_STAGE(PG8_SB(0, 0), b2, voffB);
            PG8_BAR; PG8_WAIT_L(0); PG8_MMA(0, 1, At, B1); PG8_BAR;
            PG8_LDA(At, 0, 1); PG8_STAGE(PG8_SA(0, 0), a2, voffA);
            PG8_BAR; PG8_WAIT_L(0); PG8_MMA(1, 0, At, B0); PG8_BAR; PG8_SCHED;
            PG8_STAGE(PG8_SB(0, 1), b2 + hB, voffB);
            PG8_WAIT_V(6); PG8_BAR; PG8_MMA(1, 1, At, B1); PG8_BAR;
            PG8_LDB(B0, 1, 0); PG8_SCHED; PG8_LDA(At, 1, 0); PG8_STAGE(PG8_SA(0, 1), a2 + hA, voffA);
            PG8_WAIT_L(8); PG8_BAR; PG8_WAIT_L(0); PG8_MMA(0, 0, At, B0); PG8_BAR; PG8_SCHED;
            PG8_LDB(B1, 1, 1); PG8_STAGE(PG8_SB(1, 0), b3, voffB);
            PG8_BAR; PG8_WAIT_L(0); PG8_MMA(0, 1, At, B1); PG8_BAR;
            PG8_LDA(At, 1, 1); PG8_STAGE(PG8_SA(1, 0), a3, voffA);
            PG8_BAR; PG8_WAIT_L(0); PG8_MMA(1, 0, At, B0); PG8_BAR; PG8_SCHED;
            PG8_STAGE(PG8_SB(1, 1), b3 + hB, voffB);
            PG8_WAIT_V(6); PG8_BAR; PG8_MMA(1, 1, At, B1); PG8_BAR;
            }
        }
        if constexpr (ALIGN_EPI) { if (wr == 0) PG8_BAR; }
        if constexpr (!Epi::AFTER_DRAIN) { E(acc, cur, wr, wc, fr, fq); S.done(cur); }
        if (!has_next) break;
#pragma unroll
        for (int a = 0; a < 2; ++a)
#pragma unroll
            for (int b = 0; b < 2; ++b)
#pragma unroll
                for (int m = 0; m < 4; ++m)
#pragma unroll
                    for (int n = 0; n < 2; ++n) acc[a][b][m][n] = (f32x4){0.f, 0.f, 0.f, 0.f};
        cur = nxt; cA = nA; cB = nB; ++ui;
        if constexpr (ALIGN_EPI) { if (wr == 1) PG8_BAR; }
    }
    PG8_WAIT_V(0);
    if constexpr (!ALIGN_EPI) { if (wr == 0) PG8_BAR; }
    PG8_BAR;
    if constexpr (Epi::AFTER_DRAIN) { E.fused(acc, cur, wr, wc, fr, fq, lds, wid, lane); S.done(cur); }
#undef PG8_SA
#undef PG8_SB
#undef PG8_STAGE
#undef PG8_LDA
#undef PG8_LDB
#undef PG8_MMA
#undef PG8_WAIT_V
#undef PG8_WAIT_L
#undef PG8_BAR
#undef PG8_SCHED
}
}

constexpr int NWAVES = 8;
constexpr int DM = 2048, BATCH = 8, SEQ = 2048, CTXL = 256, DFF = 5632, NMOD = 9 * DM;
constexpr int MLAT = BATCH * SEQ, MCTX = BATCH * CTXL, MALL = MLAT + MCTX;
constexpr float EPS = 1e-6f;

constexpr size_t MiB = 1u << 20;
constexpr size_t WS_CTL = 0, CTL_ZERO_BYTES = 1 * MiB;
constexpr size_t WS_WIN = 1 * MiB;
constexpr size_t WS_WOUT = 177 * MiB;
constexpr size_t WS_WRIN = 265 * MiB;
constexpr size_t WS_WROUT = 281 * MiB;
constexpr size_t WS_WFOU = 289 * MiB;
constexpr size_t WS_GW = 297 * MiB;
constexpr size_t WS_T2 = 299 * MiB;
constexpr size_t WS_TW = 315 * MiB;
constexpr size_t WS_MOD = 322 * MiB;
constexpr size_t WS_XS = 324 * MiB;
constexpr size_t WS_H = 468 * MiB;
constexpr size_t WS_ACT = 540 * MiB;
constexpr size_t WS_Y = 738 * MiB;
constexpr size_t WS_MODP = 882 * MiB;
constexpr size_t WS_YC = 894 * MiB;
constexpr size_t WS_VC = 958 * MiB;
constexpr size_t WS_SW = 1022 * MiB;
constexpr size_t WS_SA = 1023 * MiB;
constexpr size_t WS_PA = 1024 * MiB;
constexpr size_t WS_HN2 = 1026 * MiB;
constexpr size_t WS_EN2 = WS_HN2 + 65536;
constexpr size_t WS_END = 1027 * MiB;
constexpr size_t CSL = (size_t)MCTX * DM;
constexpr size_t WIN_ELEMS = (size_t)2 * DFF * DM, WOUT_ELEMS = (size_t)DM * DFF;
constexpr int CW_BAR = 4096;

constexpr int RING_OFF = 0, RING_BYTES = 131072;
constexpr int LDSCTL_OFF = 143360, MISC_OFF = LDSCTL_OFF + 320;
constexpr int LDS_BYTES = 147456;

#define GAS __attribute__((address_space(1)))
#define LAS __attribute__((address_space(3)))
typedef unsigned short bf16;
typedef unsigned v4u __attribute__((ext_vector_type(4)));
typedef unsigned v2u __attribute__((ext_vector_type(2)));
typedef float f32x4 __attribute__((ext_vector_type(4)));
typedef short bf16x8 __attribute__((ext_vector_type(8)));
typedef GAS unsigned gu32;
#define RLX_AGENT __ATOMIC_RELAXED, __HIP_MEMORY_SCOPE_AGENT
#define LDS_WAIT() asm volatile("s_waitcnt lgkmcnt(0)" ::: "memory")
#define VM_WAIT() asm volatile("s_waitcnt vmcnt(0)" ::: "memory")
__device__ __forceinline__ unsigned f2bf(float f) { unsigned u = __builtin_bit_cast(unsigned, f); return (u + 0x7fffu + ((u >> 16) & 1u)) >> 16; }
__device__ __forceinline__ unsigned pk2(float lo, float hi) { return pg8::cvt_pk_bf16(lo, hi); }
typedef _Float16 h16x2 __attribute__((ext_vector_type(2)));
__device__ __forceinline__ unsigned pkh2(float lo, float hi) { h16x2 v; v.x = (_Float16)lo; v.y = (_Float16)hi; return __builtin_bit_cast(unsigned, v); }
__device__ __forceinline__ float h_lo(unsigned w) { return (float)__builtin_bit_cast(h16x2, w).x; }
__device__ __forceinline__ float h_hi(unsigned w) { return (float)__builtin_bit_cast(h16x2, w).y; }
__device__ __forceinline__ float bf_lo(unsigned w) { return __uint_as_float(w << 16); }
__device__ __forceinline__ float bf_hi(unsigned w) { return __uint_as_float(w & 0xffff0000u); }

__device__ __forceinline__ int lane_now() { int l; asm volatile("v_mbcnt_lo_u32_b32 %0, -1, 0\n\tv_mbcnt_hi_u32_b32 %0, -1, %0" : "=v"(l)); return l; }
#define XB_TMO      128
#define XB_XCNT(j)  (256  + 64 * (j))
#define XB_XSUB(j)  (1280 + 64 * (j))
#define XB_XGEN(j)  (2304 + 64 * (j))
#define XB_TOP      3328
#define XB_TOPGEN   3392
#define XCD_BAR_WORDS 3456
#define XB_SPIN_CAP (1u << 18)

__device__ __forceinline__ unsigned xb_ld(unsigned* p)              { return __hip_atomic_load(p, __ATOMIC_RELAXED, __HIP_MEMORY_SCOPE_AGENT); }
__device__ __forceinline__ unsigned xb_add(unsigned* p, unsigned v) { return __hip_atomic_fetch_add(p, v, __ATOMIC_RELAXED, __HIP_MEMORY_SCOPE_AGENT); }
__device__ __forceinline__ unsigned xb_xcc_id() { return (unsigned)__builtin_amdgcn_s_getreg((3 << 11) | 20) & 0xFu; }
#define XB_SPIN(cond, bar) do { unsigned _sp = 0; while (cond) { __builtin_amdgcn_s_sleep(1); \
    if ((++_sp & 255u) == 0u) { if (xb_ld(&(bar)[XB_TMO])) break; if (_sp > XB_SPIN_CAP) { atomicAdd(&(bar)[XB_TMO], 1u); break; } } } } while (0)

struct XcdBarrier {
    unsigned* bar; unsigned x; int wave;
    volatile LAS unsigned* st;
};
__device__ __forceinline__ XcdBarrier xcd_barrier_post(unsigned* bar, volatile LAS unsigned* st, int wave) {
    XcdBarrier b; b.bar = bar; b.x = xb_xcc_id(); b.st = st; b.wave = wave;
    if (wave == 0 && lane_now() == 0) (void)xb_add(&bar[XB_XCNT(b.x)], 1u);
    return b;
}
__device__ __forceinline__ void xcd_barrier_complete(unsigned* bar, unsigned x, unsigned& nloc, unsigned& nx) {
    const unsigned G = gridDim.x * gridDim.y * gridDim.z;
    unsigned sum, cnt, mine, sp = 0u;
    for (;;) {
        sum = 0u; cnt = 0u; mine = 0u;
#pragma unroll
        for (unsigned j = 0; j < 16; ++j) { const unsigned c = xb_ld(&bar[XB_XCNT(j)]); sum += c; cnt += (c > 0u) ? 1u : 0u; mine = (j == x) ? c : mine; }
        if (sum == G) break;
        __builtin_amdgcn_s_sleep(1);
        if ((++sp & 255u) == 0u) { if (xb_ld(&bar[XB_TMO])) break; if (sp > XB_SPIN_CAP) { atomicAdd(&bar[XB_TMO], 1u); break; } }
    }
    nloc = mine > 0u ? mine : 1u; nx = cnt > 0u ? cnt : 1u;
}
__device__ __forceinline__ void xcd_barrier(const XcdBarrier& b) {
    asm volatile("s_waitcnt vmcnt(0)" ::: "memory");
    __syncthreads();
    if (b.wave == 0 && lane_now() == 0) {
        unsigned* bar = b.bar;
        __builtin_amdgcn_s_waitcnt(0);
        unsigned nloc = b.st[0], nx = b.st[1];
        if (nloc == 0u) { xcd_barrier_complete(bar, b.x, nloc, nx); b.st[0] = nloc; b.st[1] = nx; }
        const unsigned old = xb_add(&bar[XB_XSUB(b.x)], 1u);
        const unsigned gen = old / nloc;
        if (old + 1u == (gen + 1u) * nloc) {
            __builtin_amdgcn_fence(__ATOMIC_RELEASE, "agent");
            asm volatile("s_waitcnt vmcnt(0)" ::: "memory");
            const unsigned og = xb_add(&bar[XB_TOP], 1u);
            const unsigned tg = og / nx;
            if (og + 1u == (tg + 1u) * nx) xb_add(&bar[XB_TOPGEN], 1u);
            else XB_SPIN(xb_ld(&bar[XB_TOPGEN]) == tg, bar);
            __builtin_amdgcn_fence(__ATOMIC_ACQUIRE, "agent");
            xb_add(&bar[XB_XGEN(b.x)], 1u);
            asm volatile("s_waitcnt vmcnt(0)" ::: "memory");
        } else {
            XB_SPIN(xb_ld(&bar[XB_XGEN(b.x)]) == gen, bar);
            __builtin_amdgcn_fence(__ATOMIC_ACQUIRE, "agent");
            asm volatile("s_waitcnt vmcnt(0)" ::: "memory");
        }
    }
    __syncthreads();
}

struct Frame {
    LAS unsigned char* lds;
    volatile LAS unsigned* MISC;
    gu32* ctl;
    int wave, G;
};
__device__ __forceinline__ float wave_sum(float v) {
#pragma unroll
    for (int o = 1; o < 64; o <<= 1) v += __shfl_xor(v, o);
    return v;
}

__device__ __forceinline__ void p0_adaln(Frame& F, const float* c, const float* cctx, const float* mod_w, float* MODP) {
    const int lane = lane_now(), tid = F.wave * 64 + lane; (void)tid; (void)lane;
    LAS float* S = (LAS float*)F.lds;
    LAS float* RED = S + 9 * 256;
    for (int it = blockIdx.x; it < 2 * 8 * 72; it += F.G) {
        const int l = it / 576, rem = it % 576, kb = rem / 72, cg = rem % 72;
        __syncthreads();
        for (int i = tid; i < 9 * 256; i += NWAVES * 64) { const int r = i >> 8, k = i & 255; const float cv = (r < 8) ? c[r * DM + kb * 256 + k] : cctx[kb * 256 + k]; S[i] = cv / (1.0f + __expf(-cv)); }
        __syncthreads();
        f32x4 acc[9];
#pragma unroll
        for (int r = 0; r < 9; ++r) acc[r] = (f32x4){0.f, 0.f, 0.f, 0.f};
        const float* W = mod_w + ((size_t)l * DM + kb * 256 + F.wave * 32) * NMOD + cg * 256 + lane * 4;
        f32x4 w[8], wn[8];
#pragma unroll
        for (int e = 0; e < 8; ++e) w[e] = __builtin_nontemporal_load((const f32x4*)(W + (size_t)e * NMOD));
#pragma unroll
        for (int k = 0; k < 32; k += 8) {
            if (k + 8 < 32) {
#pragma unroll
                for (int e = 0; e < 8; ++e) wn[e] = __builtin_nontemporal_load((const f32x4*)(W + (size_t)(k + 8 + e) * NMOD)); }
#pragma unroll
            for (int r = 0; r < 9; ++r) { const f32x4 s0 = *(const LAS f32x4*)(S + r * 256 + F.wave * 32 + k), s1 = *(const LAS f32x4*)(S + r * 256 + F.wave * 32 + k + 4);
                acc[r] += w[0] * s0.x + w[1] * s0.y + w[2] * s0.z + w[3] * s0.w + w[4] * s1.x + w[5] * s1.y + w[6] * s1.z + w[7] * s1.w; }
            if (k + 8 < 32) {
#pragma unroll
                for (int e = 0; e < 8; ++e) w[e] = wn[e]; }
        }
#pragma unroll
        for (int r = 0; r < 9; ++r) *(LAS f32x4*)(RED + (F.wave * 9 + r) * 256 + lane * 4) = acc[r];
        __syncthreads();
        for (int i = tid; i < 9 * 256; i += NWAVES * 64) { const int r = i >> 8, cc = i & 255; float s = 0.f;
#pragma unroll
            for (int w = 0; w < 8; ++w) s += RED[(w * 9 + r) * 256 + cc];
            MODP[((size_t)(l * 8 + kb) * 9 + r) * NMOD + cg * 256 + cc] = s; }
    }
    __syncthreads();
}
__device__ __forceinline__ void p0_adaln_reduce(Frame& F, const float* MODP, const float* mod_b, float* MOD) {
    const int lane = lane_now(), tid = F.wave * 64 + lane; (void)tid; (void)lane;
    for (int i = blockIdx.x * (NWAVES * 64) + tid; i < 2 * 9 * NMOD; i += F.G * NWAVES * 64) {
        const int l = i / (9 * NMOD), rn = i % (9 * NMOD), n = rn % NMOD;
        float s = mod_b[l * NMOD + n];
#pragma unroll
        for (int kb = 0; kb < 8; ++kb) s += MODP[(size_t)(l * 8 + kb) * 9 * NMOD + rn];
        MOD[i] = s;
    }
}

__device__ __forceinline__ void p0_transpose_load(f32x4 (&v)[8], const float* W, int N, int k0, int n0, int lane) {
    const int kr = lane >> 3, n4 = lane & 7;
#pragma unroll
    for (int i = 0; i < 8; ++i) v[i] = __builtin_nontemporal_load((const f32x4*)(W + (size_t)(k0 + kr + 8 * i) * N + n0 + 4 * n4));
}
__device__ __forceinline__ void p0_transpose_store(const f32x4 (&v)[8], bf16* WT, int ldt, int dst_row0, LAS float* scr, int k0, int lane) {
    const int kr = lane >> 3, n4 = lane & 7;
#pragma unroll
    for (int i = 0; i < 8; ++i) { LAS float* d = scr + (kr + 8 * i) * 33 + 4 * n4; d[0] = v[i].x; d[1] = v[i].y; d[2] = v[i].z; d[3] = v[i].w; }
    LDS_WAIT(); asm volatile("" ::: "memory");
    const int c = lane & 7;
#pragma unroll
    for (int j = 0; j < 4; ++j) { const int n = (lane >> 3) + 8 * j; const LAS float* s = scr + (8 * c) * 33 + n;
        v4u o; o.x = pk2(s[0 * 33], s[1 * 33]); o.y = pk2(s[2 * 33], s[3 * 33]); o.z = pk2(s[4 * 33], s[5 * 33]); o.w = pk2(s[6 * 33], s[7 * 33]);
        *(GAS v4u*)(WT + (size_t)(dst_row0 + n) * ldt + k0 + 8 * c) = o; }
    LDS_WAIT(); asm volatile("" ::: "memory");
}
__device__ __forceinline__ void p0_quant_win(Frame& F, const float* ffn_in, unsigned char* WinQ, float* SW) {
    const int lane = lane_now(), tid = F.wave * 64 + lane; (void)lane;
    LAS unsigned char* Q = F.lds;
    LAS float* red = (LAS float*)(F.lds + 32 * 2064);
    LAS float* inv = red + 64 * 32;
    const int n4 = tid & 7, kq = tid >> 3;
    __syncthreads();
    for (int it = F.G - 1 - (int)blockIdx.x; it < 4 * 352; it += F.G) {
        const int mi = it / 352, n0 = 32 * (it % 352);
        const int s = n0 / DFF, f = n0 % DFF, drow = 256 * (f / 128) + 128 * s + (f % 128);
        const float* W = ffn_in + (size_t)mi * DM * 2 * DFF + n0 + 4 * n4;
        f32x4 v[8][4]; f32x4 mx = (f32x4){0.f, 0.f, 0.f, 0.f};
#pragma unroll
        for (int i = 0; i < 8; ++i)
#pragma unroll
            for (int e = 0; e < 4; ++e) v[i][e] = __builtin_nontemporal_load((const f32x4*)(W + (size_t)(256 * i + 4 * kq + e) * (2 * DFF)));
#pragma unroll
        for (int i = 0; i < 8; ++i)
#pragma unroll
            for (int e = 0; e < 4; ++e) { mx.x = fmaxf(mx.x, fabsf(v[i][e].x)); mx.y = fmaxf(mx.y, fabsf(v[i][e].y)); mx.z = fmaxf(mx.z, fabsf(v[i][e].z)); mx.w = fmaxf(mx.w, fabsf(v[i][e].w)); }
        *(LAS f32x4*)(red + kq * 32 + 4 * n4) = mx;
        __syncthreads();
        if (tid < 32) { float m = 0.f;
#pragma unroll 8
            for (int r = 0; r < 64; ++r) m = fmaxf(m, red[r * 32 + tid]);
            SW[(size_t)mi * 2 * DFF + drow + tid] = m > 0.f ? m * (1.0f / 127.0f) : 1.0f; inv[tid] = m > 0.f ? 127.0f / m : 0.f; }
        __syncthreads();
        const f32x4 iv = *(const LAS f32x4*)(inv + 4 * n4);
#pragma unroll
        for (int i = 0; i < 8; ++i)
#pragma unroll
            for (int c = 0; c < 4; ++c) { unsigned p = 0u;
#pragma unroll
                for (int e = 0; e < 4; ++e) p |= ((unsigned)(int)__builtin_rintf(v[i][e][c] * iv[c]) & 0xffu) << (8 * e);
                *(LAS unsigned*)(Q + (4 * n4 + c) * 2064 + 256 * i + 4 * kq) = p; }
        __syncthreads();
        { const int row = tid >> 4, seg = tid & 15;
#pragma unroll
          for (int j = 0; j < 8; ++j) *(GAS v4u*)(WinQ + ((size_t)mi * 2 * DFF + drow + row) * DM + 16 * (seg + 16 * j)) = *(const LAS v4u*)(Q + row * 2064 + 16 * (seg + 16 * j)); }
        __syncthreads();
    }
}
struct WeightPtrs { const float *ffn_out, *rec_in, *rec_out, *fou_out, *gate_w; bf16 *WoutT, *WrinT, *WroutT, *WfouT, *GW; };
__device__ __forceinline__ void p0_weights(Frame& F, const WeightPtrs& P) {
    const int lane = lane_now(), tid = F.wave * 64 + lane; (void)tid; (void)lane;
    LAS float* scr = (LAS float*)(F.lds + RING_OFF + F.wave * 16384);
    const int gw = blockIdx.x * NWAVES + F.wave, NGW = F.G * NWAVES;
    constexpr int I_OUT = (DFF / 64) * (DM / 32), I_RIN = (DM / 64) * (2 * DM / 32), I_SQ = (DM / 64) * (DM / 32), I_G = 2 * 4;
    constexpr int NITEMS = 4 * I_OUT + I_RIN + 2 * I_SQ + 64 * I_G;
#define P0_ITEM(it_, W_, N_, WT_, ldt_, drow_, k0_, n0_) do { int r_ = (it_); \
        if (r_ < 4 * I_OUT) { const int mi = r_ / I_OUT, q = r_ % I_OUT, nblk = DM / 32; W_ = P.ffn_out + (size_t)mi * DFF * DM; N_ = DM; k0_ = 64 * (q / nblk); n0_ = 32 * (q % nblk); WT_ = P.WoutT + (size_t)mi * WOUT_ELEMS + ((size_t)(n0_ >> 8) * (DFF / 64) + (k0_ >> 6)) * 16384; ldt_ = 64; }     \
        else if ((r_ -= 4 * I_OUT) < I_RIN) { const int nblk = 2 * DM / 32; W_ = P.rec_in; N_ = 2 * DM; WT_ = P.WrinT; ldt_ = DM; k0_ = 64 * (r_ / nblk); n0_ = 32 * (r_ % nblk); } \
        else if ((r_ -= I_RIN) < 2 * I_SQ) { const int mi = r_ / I_SQ, q = r_ % I_SQ, nblk = DM / 32; W_ = mi ? P.fou_out : P.rec_out; N_ = DM; WT_ = mi ? P.WfouT : P.WroutT; ldt_ = DM; k0_ = 64 * (q / nblk); n0_ = 32 * (q % nblk); } \
        else { r_ -= 2 * I_SQ; const int mi = r_ / I_G, q = r_ % I_G; W_ = P.gate_w + (size_t)mi * 128 * 128; N_ = 128; WT_ = P.GW + (size_t)mi * 128 * 128; ldt_ = 128; k0_ = 64 * (q / 4); n0_ = 32 * (q % 4); } \
        drow_ = ldt_ == 64 ? (n0_ & 255) : n0_; } while (0)
    const float* Wc; bf16* WTc; int Nc, ldc, drc, k0c, n0c; f32x4 vc[8];
    int it = gw;
    if (it < NITEMS) { P0_ITEM(it, Wc, Nc, WTc, ldc, drc, k0c, n0c); p0_transpose_load(vc, Wc, Nc, k0c, n0c, lane); }
    while (it < NITEMS) {
        const int nx = it + NGW; const float* Wn = Wc; bf16* WTn = WTc; int Nn = Nc, ldn = ldc, drn = drc, k0n = k0c, n0n = n0c; f32x4 vn[8];
        if (nx < NITEMS) { P0_ITEM(nx, Wn, Nn, WTn, ldn, drn, k0n, n0n); p0_transpose_load(vn, Wn, Nn, k0n, n0n, lane); }
        p0_transpose_store(vc, WTc, ldc, drc, scr, ldc == 64 ? 0 : k0c, lane);
        if (nx < NITEMS) {
#pragma unroll
            for (int i = 0; i < 8; ++i) vc[i] = vn[i];
            Wc = Wn; WTc = WTn; Nc = Nn; ldc = ldn; drc = drn; k0c = k0n; n0c = n0n; }
        it = nx;
    }
#undef P0_ITEM
}
__device__ __forceinline__ void p0_twiddles(Frame& F, bf16* T2, bf16* TW) {
    const int lane = lane_now(), tid = F.wave * 64 + lane; (void)tid; (void)lane;
    const int gt = blockIdx.x * (NWAVES * 64) + tid, NGT = F.G * NWAVES * 64;
    for (int i = gt; i < 1024 * 2048 / 8; i += NGT) {
        const int k1 = i >> 8, col = (i & 255) * 8, cs = col >> 10, n0 = col & 1023;
        float v[8];
#pragma unroll
        for (int e = 0; e < 8; ++e) { const int m = (k1 * (n0 + e)) & 2047; const float ang = (float)m * (1.0f / 1024.0f); v[e] = cs ? -sinpif(ang) : cospif(ang); }
        v4u o; o.x = pk2(v[0], v[1]); o.y = pk2(v[2], v[3]); o.z = pk2(v[4], v[5]); o.w = pk2(v[6], v[7]);
        *(GAS v4u*)(T2 + (size_t)i * 8) = o;
    }
    for (int i = gt; i < 512 * 256 / 8; i += NGT) {
        const int row = i >> 5, c0 = (i & 31) * 8, cs = row >> 8, k2 = row & 255;
        float v[8];
#pragma unroll
        for (int e = 0; e < 8; ++e) { const int m = (k2 * (c0 + e)) & 255; const float ang = (float)m * (1.0f / 128.0f); v[e] = cs ? sinpif(ang) : cospif(ang); }
        v4u o; o.x = pk2(v[0], v[1]); o.y = pk2(v[2], v[3]); o.z = pk2(v[4], v[5]); o.w = pk2(v[6], v[7]);
        *(GAS v4u*)(TW + (size_t)i * 8) = o;
    }
}

template <bool RES, bool HOUT, bool CTX, bool XIN16, bool XOUT16, bool H8, bool ALT = false, bool MODRAW = false>
__device__ __forceinline__ void thin_phase(Frame& F, const void* xl, const void* xc, const bf16* Yb, const bf16* YC, void* ol, bf16* H, float* SA, float* PA,
                                           const float* gpost, const float* modr, int gate_ch, float coef, const float* gpre, const float* modn, int sh_ch, int sc_ch,
                                           const float* MODPr = nullptr, const float* modb = nullptr) {
    auto modv = [&](int row, int ch, int i) -> float {
        if (!MODRAW) return modn[(row * 9 + ch) * DM + i];
        const int n = ch * DM + i; float s = modb[n];
#pragma unroll
        for (int kb = 0; kb < 8; ++kb) s += MODPr[((size_t)kb * 9 + row) * NMOD + n];
        return s; };
    const int lane = lane_now(), tid = F.wave * 64 + lane; (void)tid; (void)lane;
    LAS float* VA = (LAS float*)F.lds;
    LAS float* VB = VA + 2 * DM;
    LAS float* VC = VB + 2 * DM;
    for (int vb = blockIdx.x; vb < 256; vb += F.G) {
        const int b = vb >> 5;
        __syncthreads();
        for (int i = tid; i < DM; i += NWAVES * 64) {
            if (RES) { const float gp = coef * gpost[i]; VA[i] = gp * modr[(b * 9 + gate_ch) * DM + i]; if (CTX) VA[DM + i] = gp * modr[(8 * 9 + gate_ch) * DM + i]; }
            if (HOUT) { const float gq = gpre[i]; VB[i] = gq * (1.0f + modv(b, sc_ch, i)); VC[i] = modv(b, sh_ch, i);
                if (CTX) { VB[DM + i] = gq * (1.0f + modv(8, sc_ch, i)); VC[DM + i] = modv(8, sh_ch, i); } }
        }
        __syncthreads();
        f32x4 alt[8];
#pragma unroll
        for (int j = 0; j < 8; ++j) alt[j] = (f32x4){0.f, 0.f, 0.f, 0.f};
        constexpr bool PF = XIN16 && RES && !CTX;
        v2u xnx[8], ynx[8];
        if (PF) { const v2u* xr = (const v2u*)((const unsigned short*)xl + (size_t)(vb * 64 + F.wave) * DM) + lane; const v2u* yr = (const v2u*)(Yb + (size_t)(vb * 64 + F.wave) * DM) + lane;
#pragma unroll
            for (int j = 0; j < 8; ++j) { xnx[j] = __builtin_nontemporal_load(xr + 64 * j); ynx[j] = __builtin_nontemporal_load(yr + 64 * j); } }
        for (int rr = F.wave; rr < (CTX ? 72 : 64); rr += NWAVES) {
            const bool isctx = rr >= 64; const int lrow = isctx ? vb * 8 + (rr - 64) : vb * 64 + rr, row = isctx ? MLAT + lrow : lrow, vo = isctx ? DM / 4 : 0;
            f32x4 xv[8]; v2u xcu[8], ycu[8];
            if (PF) {
#pragma unroll
                for (int j = 0; j < 8; ++j) { xcu[j] = xnx[j]; ycu[j] = ynx[j]; }
                if (rr + NWAVES < 64) { const v2u* xr = (const v2u*)((const unsigned short*)xl + (size_t)(lrow + NWAVES) * DM) + lane; const v2u* yr = (const v2u*)(Yb + (size_t)(lrow + NWAVES) * DM) + lane;
#pragma unroll
                    for (int j = 0; j < 8; ++j) { xnx[j] = __builtin_nontemporal_load(xr + 64 * j); ynx[j] = __builtin_nontemporal_load(yr + 64 * j); } }
            }
            if (XIN16) { const v2u* xr = (const v2u*)((const unsigned short*)xl + (size_t)lrow * DM) + lane;
#pragma unroll
                for (int j = 0; j < 8; ++j) { const v2u w = PF ? xcu[j] : __builtin_nontemporal_load(xr + 64 * j); xv[j] = (f32x4){h_lo(w.x), h_hi(w.x), h_lo(w.y), h_hi(w.y)}; }
            } else { const f32x4* xr = (const f32x4*)((const float*)(isctx ? xc : xl) + (size_t)lrow * DM) + lane;
#pragma unroll
                for (int j = 0; j < 8; ++j) xv[j] = __builtin_nontemporal_load(xr + 64 * j); }
            if (RES) {
                f32x4 yv[8]; float ss = 0.f;
                if (!isctx) { const v2u* yr = (const v2u*)(Yb + (size_t)row * DM) + lane;
#pragma unroll
                    for (int j = 0; j < 8; ++j) { const v2u w = PF ? ycu[j] : __builtin_nontemporal_load(yr + 64 * j); yv[j] = (f32x4){bf_lo(w.x), bf_hi(w.x), bf_lo(w.y), bf_hi(w.y)}; }
                } else { const v2u* yr = (const v2u*)(YC + (size_t)lrow * DM) + lane;
#pragma unroll
                    for (int j = 0; j < 8; ++j) { const v2u w0 = yr[64 * j], w1 = yr[CSL / 4 + 64 * j], w2 = yr[2 * (CSL / 4) + 64 * j], w3 = yr[3 * (CSL / 4) + 64 * j];
                        yv[j] = (f32x4){(bf_lo(w0.x) + bf_lo(w1.x)) + (bf_lo(w2.x) + bf_lo(w3.x)), (bf_hi(w0.x) + bf_hi(w1.x)) + (bf_hi(w2.x) + bf_hi(w3.x)),
                                        (bf_lo(w0.y) + bf_lo(w1.y)) + (bf_lo(w2.y) + bf_lo(w3.y)), (bf_hi(w0.y) + bf_hi(w1.y)) + (bf_hi(w2.y) + bf_hi(w3.y))}; } }
#pragma unroll
                for (int j = 0; j < 8; ++j) ss += (yv[j].x * yv[j].x + yv[j].y * yv[j].y) + (yv[j].z * yv[j].z + yv[j].w * yv[j].w);
                const float rstd = rsqrtf(wave_sum(ss) * (1.0f / DM) + EPS);
#pragma unroll
                for (int j = 0; j < 8; ++j) { const f32x4 va = ((const LAS f32x4*)VA)[vo + 64 * j + lane]; xv[j] = xv[j] + va * yv[j] * rstd; }
                if (!isctx) {
                    if (XOUT16) { GAS v2u* orow = (GAS v2u*)((unsigned short*)ol + (size_t)lrow * DM) + lane;
#pragma unroll
                        for (int j = 0; j < 8; ++j) { v2u o; o.x = pkh2(xv[j].x, xv[j].y); o.y = pkh2(xv[j].z, xv[j].w); __builtin_nontemporal_store(o, orow + 64 * j);
                            if (HOUT) xv[j] = (f32x4){h_lo(o.x), h_hi(o.x), h_lo(o.y), h_hi(o.y)}; }
                    } else { f32x4* orow = (f32x4*)((float*)ol + (size_t)lrow * DM) + lane;
#pragma unroll
                        for (int j = 0; j < 8; ++j) orow[64 * j] = xv[j]; }
                }
            }
            if (HOUT) {
                float ss = 0.f;
#pragma unroll
                for (int j = 0; j < 8; ++j) ss += (xv[j].x * xv[j].x + xv[j].y * xv[j].y) + (xv[j].z * xv[j].z + xv[j].w * xv[j].w);
                const float rstd = rsqrtf(wave_sum(ss) * (1.0f / DM) + EPS);
                if (H8) {
                    float am = 0.f;
#pragma unroll
                    for (int j = 0; j < 8; ++j) { const f32x4 vb4 = ((const LAS f32x4*)VB)[vo + 64 * j + lane], vc4 = ((const LAS f32x4*)VC)[vo + 64 * j + lane];
                        xv[j] = xv[j] * rstd * vb4 + vc4; am = fmaxf(fmaxf(am, fmaxf(fabsf(xv[j].x), fabsf(xv[j].y))), fmaxf(fabsf(xv[j].z), fabsf(xv[j].w))); }
#pragma unroll
                    for (int o = 1; o < 64; o <<= 1) am = fmaxf(am, __shfl_xor(am, o));
                    const float inv = am > 0.f ? 127.0f / am : 0.f;
                    if (lane == 0) SA[row] = am > 0.f ? am * (1.0f / 127.0f) : 1.0f;
                    GAS unsigned* hrow = (GAS unsigned*)((unsigned char*)H + (size_t)row * DM) + lane;
#pragma unroll
                    for (int j = 0; j < 8; ++j) hrow[64 * j] = ((unsigned)(int)__builtin_rintf(xv[j].x * inv) & 0xffu) | (((unsigned)(int)__builtin_rintf(xv[j].y * inv) & 0xffu) << 8)
                                                             | (((unsigned)(int)__builtin_rintf(xv[j].z * inv) & 0xffu) << 16) | ((unsigned)(int)__builtin_rintf(xv[j].w * inv) << 24);
                } else {
                GAS v2u* hrow = (GAS v2u*)(H + (size_t)row * DM) + lane;
#pragma unroll
                for (int j = 0; j < 8; ++j) { const f32x4 vb4 = ((const LAS f32x4*)VB)[vo + 64 * j + lane], vc4 = ((const LAS f32x4*)VC)[vo + 64 * j + lane];
                    const f32x4 h = xv[j] * rstd * vb4 + vc4; v2u o; o.x = pk2(h.x, h.y); o.y = pk2(h.z, h.w); hrow[64 * j] = o;
                    if (ALT) alt[j] += (lrow & 1) ? -h : h; }
                }
            }
        }
        if (ALT) {
            LAS float* AL = VC + 2 * DM;
#pragma unroll
            for (int j = 0; j < 8; ++j) *(LAS f32x4*)(AL + F.wave * DM + 4 * (64 * j + lane)) = alt[j];
            __syncthreads();
            for (int i = tid; i < DM; i += NWAVES * 64) { float s = 0.f;
#pragma unroll
                for (int w = 0; w < 8; ++w) s += AL[w * DM + i];
                PA[(size_t)vb * DM + i] = s; }
        }
    }
    __syncthreads();
}

__device__ __forceinline__ void fold_row(const v2u (&xr)[8], const v2u (&yr)[8], unsigned short* XSp, int lrow, int lane, const LAS float* VA, const LAS float* VB, const LAS float* VC, f32x4 (&h)[8]) {
    f32x4 yv[8]; float ss = 0.f;
#pragma unroll
    for (int j = 0; j < 8; ++j) { h[j] = (f32x4){h_lo(xr[j].x), h_hi(xr[j].x), h_lo(xr[j].y), h_hi(xr[j].y)}; yv[j] = (f32x4){bf_lo(yr[j].x), bf_hi(yr[j].x), bf_lo(yr[j].y), bf_hi(yr[j].y)}; }
#pragma unroll
    for (int j = 0; j < 8; ++j) ss += (yv[j].x * yv[j].x + yv[j].y * yv[j].y) + (yv[j].z * yv[j].z + yv[j].w * yv[j].w);
    const float rstd = rsqrtf(wave_sum(ss) * (1.0f / DM) + EPS);
    GAS v2u* orow = (GAS v2u*)(XSp + (size_t)lrow * DM) + lane;
    float s2 = 0.f;
#pragma unroll
    for (int j = 0; j < 8; ++j) { const f32x4 va = ((const LAS f32x4*)VA)[64 * j + lane]; const f32x4 xn = h[j] + va * yv[j] * rstd;
        v2u o; o.x = pkh2(xn.x, xn.y); o.y = pkh2(xn.z, xn.w); __builtin_nontemporal_store(o, orow + 64 * j);
        h[j] = (f32x4){h_lo(o.x), h_hi(o.x), h_lo(o.y), h_hi(o.y)};
        s2 += (h[j].x * h[j].x + h[j].y * h[j].y) + (h[j].z * h[j].z + h[j].w * h[j].w); }
    const float rstd2 = rsqrtf(wave_sum(s2) * (1.0f / DM) + EPS);
#pragma unroll
    for (int j = 0; j < 8; ++j) { const f32x4 vb4 = ((const LAS f32x4*)VB)[64 * j + lane], vc4 = ((const LAS f32x4*)VC)[64 * j + lane]; h[j] = h[j] * rstd2 * vb4 + vc4; }
}
__device__ __forceinline__ void thin_fold_phase(Frame& F, unsigned short* XSp, const bf16* Yb, bf16* H, float* PA, float* HN2,
                                                const float* gpost, const float* modr, int gate_ch, float coef, const float* gpre, const float* modn, int sh_ch, int sc_ch) {
    const int lane = lane_now(), tid = F.wave * 64 + lane; (void)tid; (void)lane;
    LAS float* VA = (LAS float*)F.lds; LAS float* VB = VA + 2 * DM; LAS float* VC = VB + 2 * DM;
    for (int vb = blockIdx.x; vb < 256; vb += F.G) {
        const int b = vb >> 5, jb = vb & 31;
        __syncthreads();
        for (int i = tid; i < DM; i += NWAVES * 64) {
            VA[i] = coef * gpost[i] * modr[(b * 9 + gate_ch) * DM + i];
            VB[i] = gpre[i] * (1.0f + modn[(b * 9 + sc_ch) * DM + i]); VC[i] = modn[(b * 9 + sh_ch) * DM + i]; }
        __syncthreads();
        f32x4 alt[8];
#pragma unroll
        for (int j = 0; j < 8; ++j) alt[j] = (f32x4){0.f, 0.f, 0.f, 0.f};
        v2u xc[8], yc[8], xn[8], yn[8];
        { const int n0 = 32 * jb + F.wave; const v2u* p0 = (const v2u*)(XSp + (size_t)(b * SEQ + n0) * DM) + lane; const v2u* p1 = (const v2u*)(Yb + (size_t)(b * SEQ + n0) * DM) + lane;
#pragma unroll
          for (int j = 0; j < 8; ++j) { xc[j] = __builtin_nontemporal_load(p0 + 64 * j); yc[j] = __builtin_nontemporal_load(p1 + 64 * j); } }
        for (int rr = F.wave; rr < 32; rr += NWAVES) {
            const int n = 32 * jb + rr, m = n ? SEQ - n : SEQ / 2, rowa = b * SEQ + n, rowb = b * SEQ + m;
            { const v2u* p2 = (const v2u*)(XSp + (size_t)rowb * DM) + lane; const v2u* p3 = (const v2u*)(Yb + (size_t)rowb * DM) + lane;
#pragma unroll
              for (int j = 0; j < 8; ++j) { xn[j] = __builtin_nontemporal_load(p2 + 64 * j); yn[j] = __builtin_nontemporal_load(p3 + 64 * j); } }
            f32x4 hA[8], hB[8];
            fold_row(xc, yc, XSp, rowa, lane, VA, VB, VC, hA);
            asm volatile("" ::: "memory");
            if (rr + NWAVES < 32) { const int rown = rowa + NWAVES; const v2u* p0 = (const v2u*)(XSp + (size_t)rown * DM) + lane; const v2u* p1 = (const v2u*)(Yb + (size_t)rown * DM) + lane;
#pragma unroll
                for (int j = 0; j < 8; ++j) { xc[j] = __builtin_nontemporal_load(p0 + 64 * j); yc[j] = __builtin_nontemporal_load(p1 + 64 * j); } }
            fold_row(xn, yn, XSp, rowb, lane, VA, VB, VC, hB);
            GAS v2u* srow = (GAS v2u*)(H + (size_t)(b * SEQ + n) * DM) + lane; GAS v2u* drow = (GAS v2u*)(H + (size_t)(b * SEQ + SEQ / 2 + n) * DM) + lane;
            if (n) {
#pragma unroll
                for (int j = 0; j < 8; ++j) { const f32x4 hs = hA[j] + hB[j], hd = hA[j] - hB[j]; v2u o; o.x = pk2(hs.x, hs.y); o.y = pk2(hs.z, hs.w); srow[64 * j] = o;
                    v2u q; q.x = pk2(hd.x, hd.y); q.y = pk2(hd.z, hd.w); drow[64 * j] = q; alt[j] += (n & 1) ? -hs : hs; }
            } else {
                f32x4* nrow = (f32x4*)(HN2 + (size_t)b * DM) + lane;
#pragma unroll
                for (int j = 0; j < 8; ++j) { v2u o; o.x = pk2(hA[j].x, hA[j].y); o.y = pk2(hA[j].z, hA[j].w); srow[64 * j] = o; drow[64 * j] = (v2u){0u, 0u}; nrow[64 * j] = hB[j]; alt[j] += hA[j] + hB[j]; }
            }
        }
        {
            LAS float* AL = VC + 2 * DM;
#pragma unroll
            for (int j = 0; j < 8; ++j) *(LAS f32x4*)(AL + F.wave * DM + 4 * (64 * j + lane)) = alt[j];
            __syncthreads();
            for (int i = tid; i < DM; i += NWAVES * 64) { float s = 0.f;
#pragma unroll
                for (int w = 0; w < 8; ++w) s += AL[w * DM + i];
                PA[(size_t)vb * DM + i] = s; }
        }
    }
    __syncthreads();
}

constexpr int VROW = 272;
constexpr int SC_IMG = 64 * VROW, SC_CTX = 4 * SC_IMG;
static_assert(SC_CTX + 4 * SC_IMG <= 143360 && 259 * 256 <= 4 * SC_IMG, "scan LDS");
__device__ __forceinline__ int rho_of(int t) { return 16 * ((t >> 2) & 3) + 4 * (t >> 4) + (t & 3); }
__device__ __forceinline__ void scan_phase(Frame& F, const bf16* VCV, const bf16* VC, bf16* G, bf16* YP, const bf16* GW, const float* conv_w, const float* conv_b, const float* gate_b, const float* lam) {
    const int lane = lane_now(), tid = F.wave * 64 + lane; (void)tid; (void)lane;
    const int hb = F.wave >> 2, wv = F.wave & 3, th = tid & 255, jj = lane & 15, g = lane >> 4, d = hb;
    LAS unsigned char* CTXI = F.lds;
    LAS unsigned char* IMG = F.lds + SC_CTX + hb * 2 * SC_IMG;
    LAS unsigned char* RAW = F.lds + SC_CTX;
    for (int u = blockIdx.x; u < 256; u += F.G) {
        const int b = u >> 5, q = u & 31, hd = q >> 1, half = q & 1, ch0 = hd * 128, jl = half * 64 + wv * 16 + jj, cj = ch0 + jl;
        const int col16 = tid & 15;
        __syncthreads();
        if (tid < 48) *(LAS v4u*)(RAW + ((tid >> 4) == 2 ? 258 : (tid >> 4)) * 256 + col16 * 16) = (v4u){0u, 0u, 0u, 0u};
#pragma unroll 2
        for (int it = 0; it < 8; ++it) { const int tok = (tid >> 4) + 32 * it; const bf16* p = VC + (size_t)(b * CTXL + tok) * DM + ch0 + 8 * col16;
            const v4u p0 = *(const v4u*)p, p1 = *(const v4u*)(p + CSL), p2 = *(const v4u*)(p + 2 * CSL), p3 = *(const v4u*)(p + 3 * CSL);
            v4u w;
            w.x = pk2((bf_lo(p0.x) + bf_lo(p1.x)) + (bf_lo(p2.x) + bf_lo(p3.x)), (bf_hi(p0.x) + bf_hi(p1.x)) + (bf_hi(p2.x) + bf_hi(p3.x)));
            w.y = pk2((bf_lo(p0.y) + bf_lo(p1.y)) + (bf_lo(p2.y) + bf_lo(p3.y)), (bf_hi(p0.y) + bf_hi(p1.y)) + (bf_hi(p2.y) + bf_hi(p3.y)));
            w.z = pk2((bf_lo(p0.z) + bf_lo(p1.z)) + (bf_lo(p2.z) + bf_lo(p3.z)), (bf_hi(p0.z) + bf_hi(p1.z)) + (bf_hi(p2.z) + bf_hi(p3.z)));
            w.w = pk2((bf_lo(p0.w) + bf_lo(p1.w)) + (bf_lo(p2.w) + bf_lo(p3.w)), (bf_hi(p0.w) + bf_hi(p1.w)) + (bf_hi(p2.w) + bf_hi(p3.w)));
            *(LAS v4u*)(RAW + (tok + 2) * 256 + col16 * 16) = w; }
        __syncthreads();
        { float cw[4][8], cb[8];
#pragma unroll
          for (int e = 0; e < 8; ++e) { cb[e] = conv_b[ch0 + 8 * col16 + e];
#pragma unroll
              for (int k = 0; k < 4; ++k) cw[k][e] = conv_w[k * DM + ch0 + 8 * col16 + e]; }
#pragma unroll 2
          for (int it = 0; it < 8; ++it) { const int tok = (tid >> 4) + 32 * it; float o[8];
#pragma unroll
              for (int e = 0; e < 8; ++e) o[e] = cb[e];
#pragma unroll
              for (int kk = 0; kk < 4; ++kk) { const v4u r = *(const LAS v4u*)(RAW + (tok + kk) * 256 + col16 * 16);
                  o[0] += cw[kk][0] * bf_lo(r.x); o[1] += cw[kk][1] * bf_hi(r.x); o[2] += cw[kk][2] * bf_lo(r.y); o[3] += cw[kk][3] * bf_hi(r.y);
                  o[4] += cw[kk][4] * bf_lo(r.z); o[5] += cw[kk][5] * bf_hi(r.z); o[6] += cw[kk][6] * bf_lo(r.w); o[7] += cw[kk][7] * bf_hi(r.w); }
              v4u w; w.x = pk2(o[0], o[1]); w.y = pk2(o[2], o[3]); w.z = pk2(o[4], o[5]); w.w = pk2(o[6], o[7]);
              *(LAS v4u*)(CTXI + (tok >> 6) * SC_IMG + rho_of(tok & 63) * VROW + col16 * 16) = w; } }
        const float ba = gate_b[(d * 2 + 0) * DM + cj], bx = gate_b[(d * 2 + 1) * DM + cj];
        const float lm = lam[d * DM + cj];
        const float sp = fmaxf(-lm, 0.f) + log1pf(__expf(-fabsf(lm)));
        const float cneg2 = -8.0f * sp * 1.4426950408889634f;
        bf16x8 Bf[2][4];
#pragma unroll
        for (int gt = 0; gt < 2; ++gt)
#pragma unroll
            for (int s = 0; s < 4; ++s) Bf[gt][s] = *(const bf16x8*)(GW + ((size_t)((d * 2 + gt) * 16 + hd) * 128 + jl) * 128 + 32 * s + 8 * g);
        const int trow = th >> 4;
        float carry = 0.f;
        v4u vpre[4];
        __syncthreads();
#define SCAN_CHUNK(j, isctx, cidx, rowbase) const bool isctx = (j) < 4; const int cidx = isctx ? (d ? 3 - (j) : (j)) : (d ? 35 - (j) : (j) - 4); const int rowbase = b * SEQ + 64 * cidx;
        for (int k = 0; k < 36; ++k) {
            SCAN_CHUNK(k, isctx, cidx, rowbase)
            const bool fin = !isctx && (d ? cidx <= 15 : cidx >= 16);
            if (k + 1 >= 4 && k + 1 < 36) {
#pragma unroll
                for (int it = 0; it < 4; ++it) *(LAS v4u*)(IMG + ((k + 1) & 1) * SC_IMG + rho_of(trow + 16 * it) * VROW + col16 * 16) = vpre[it]; }
            if (k + 2 >= 4 && k + 2 < 36) { SCAN_CHUNK(k + 2, pc_, pi_, pr_) (void)pc_; (void)pi_;
#pragma unroll
                for (int it = 0; it < 4; ++it) vpre[it] = *(const v4u*)(VCV + (size_t)(pr_ + trow + 16 * it) * DM + ch0 + 8 * col16); }
            float yp[16]; unsigned gg[16];
            if (fin) {
#pragma unroll
                for (int i = 0; i < 16; ++i) { const size_t off = (size_t)(rowbase + 16 * g + i) * DM + cj; yp[i] = __uint_as_float((unsigned)YP[off] << 16); gg[i] = G[off]; }
            }
            const LAS unsigned char* VCk = isctx ? (const LAS unsigned char*)(CTXI + cidx * SC_IMG) : (const LAS unsigned char*)(IMG + (k & 1) * SC_IMG);
            f32x4 Cr[4], Ci[4];
#pragma unroll
            for (int m = 0; m < 4; ++m) { Cr[m] = (f32x4){0.f, 0.f, 0.f, 0.f}; Ci[m] = (f32x4){0.f, 0.f, 0.f, 0.f}; }
#pragma unroll
            for (int s = 0; s < 4; ++s)
#pragma unroll
                for (int m = 0; m < 4; ++m) { const bf16x8 a = *(const LAS bf16x8*)(VCk + (16 * m + jj) * VROW + (32 * s + 8 * g) * 2);
                    Cr[m] = __builtin_amdgcn_mfma_f32_16x16x32_bf16(a, Bf[0][s], Cr[m], 0, 0, 0);
                    Ci[m] = __builtin_amdgcn_mfma_f32_16x16x32_bf16(a, Bf[1][s], Ci[m], 0, 0, 0); }
            float av[16], bv[16];
#pragma unroll
            for (int m = 0; m < 4; ++m)
#pragma unroll
                for (int r = 0; r < 4; ++r) { const int i = 4 * m + r;
                    const float vc = __uint_as_float((unsigned)(*(const LAS unsigned short*)(VCk + (16 * m + 4 * g + r) * VROW + jl * 2)) << 16);
                    const float rg = pg8::sigmoid_f(Cr[m][r] + ba), ig = pg8::sigmoid_f(Ci[m][r] + bx);
                    const float a = __builtin_amdgcn_exp2f(rg * cneg2);
                    av[i] = a; bv[i] = __builtin_amdgcn_sqrtf(fmaxf(1.0f - a * a, 0.f)) * ig * vc; }
            float P = 1.f, Hh = 0.f;
            if (d == 0) {
#pragma unroll
                for (int i = 0; i < 16; ++i) { Hh = av[i] * Hh + bv[i]; P *= av[i]; }
            } else {
#pragma unroll
                for (int i = 15; i >= 0; --i) { Hh = av[i] * Hh + bv[i]; P *= av[i]; }
            }
            float Pk[4], Hk[4];
#pragma unroll
            for (int kk = 0; kk < 4; ++kk) { Pk[kk] = __shfl(P, jj + 16 * kk); Hk[kk] = __shfl(Hh, jj + 16 * kk); }
            float s = carry, cin = 0.f;
            if (d == 0) {
#pragma unroll
                for (int kk = 0; kk < 4; ++kk) { if (kk == g) cin = s; s = Pk[kk] * s + Hk[kk]; }
            } else {
#pragma unroll
                for (int kk = 3; kk >= 0; --kk) { if (kk == g) cin = s; s = Pk[kk] * s + Hk[kk]; }
            }
            carry = s;
            if (!isctx) {
                float h = cin;
                if (d == 0) {
#pragma unroll
                    for (int i = 0; i < 16; ++i) { h = av[i] * h + bv[i]; av[i] = h; }
                } else {
#pragma unroll
                    for (int i = 15; i >= 0; --i) { h = av[i] * h + bv[i]; av[i] = h; }
                }
                if (fin) {
#pragma unroll
                    for (int i = 0; i < 16; ++i) { const size_t off = (size_t)(rowbase + 16 * g + i) * DM + cj; G[off] = (bf16)f2bf(__uint_as_float(gg[i] << 16) * (av[i] + yp[i])); }
                } else {
#pragma unroll
                    for (int i = 0; i < 16; ++i) { const size_t off = (size_t)(rowbase + 16 * g + i) * DM + cj; YP[off] = (bf16)f2bf(av[i]); }
                }
            }
            if (k == 19) VM_WAIT();
            __syncthreads();
        }
#undef SCAN_CHUNK
    }
}

struct Args { const float* in[17]; float* out; unsigned char* ws; };
__global__ void __launch_bounds__(NWAVES * 64, 2) fwd_kernel(Args args) {
    extern __shared__ __attribute__((aligned(16))) unsigned char lds[];
    Frame F;
    F.lds = (LAS unsigned char*)lds;
    F.MISC = (volatile LAS unsigned*)(F.lds + MISC_OFF);
    F.wave = __builtin_amdgcn_readfirstlane((int)threadIdx.x >> 6);
    F.G = gridDim.x;
    const int lane = lane_now(), tid = F.wave * 64 + lane; (void)lane;
    unsigned char* ws = args.ws;
    F.ctl = (gu32*)(ws + WS_CTL);
    for (int u = tid; u < (LDS_BYTES - LDSCTL_OFF) / 4; u += NWAVES * 64) ((LAS unsigned*)(F.lds + LDSCTL_OFF))[u] = 0u;
    __syncthreads();
    XcdBarrier bar = xcd_barrier_post((unsigned*)(F.ctl + CW_BAR), F.MISC + 8, F.wave);
#ifdef PROBE_TS
    volatile LAS unsigned long long* TS = (volatile LAS unsigned long long*)(F.lds + MISC_OFF + 128);
    int ts_n = 0;
    volatile LAS unsigned long long* TC = TS + 32;
#define GRID_BAR() do { xcd_barrier(bar); if (tid == 0) { TS[ts_n] = __builtin_amdgcn_s_memrealtime(); TC[ts_n] = (unsigned long long)clock64(); } ++ts_n; } while (0)
    if (tid == 0) { TS[ts_n] = __builtin_amdgcn_s_memrealtime(); TC[ts_n] = (unsigned long long)clock64(); } ++ts_n;
#else
#define GRID_BAR() xcd_barrier(bar)
#endif

    const float* x_in = args.in[0]; const float* c_in = args.in[1]; const float* ctx_in = args.in[2]; const float* cctx_in = args.in[3];
    const float* mod_w = args.in[4]; const float* mod_b = args.in[5]; const float* norm_g = args.in[6];
    unsigned char* WinQ = (unsigned char*)(ws + WS_WIN); float* SW = (float*)(ws + WS_SW); float* SA = (float*)(ws + WS_SA); float* PA = (float*)(ws + WS_PA); float* HN2 = (float*)(ws + WS_HN2); float* EN2 = (float*)(ws + WS_EN2); float* const PAn = nullptr; bf16* WoutT = (bf16*)(ws + WS_WOUT); bf16* WrinT = (bf16*)(ws + WS_WRIN); bf16* WroutT = (bf16*)(ws + WS_WROUT); bf16* WfouT = (bf16*)(ws + WS_WFOU);
    bf16* GW = (bf16*)(ws + WS_GW); bf16* T2 = (bf16*)(ws + WS_T2); bf16* TW = (bf16*)(ws + WS_TW);
    float* MODP = (float*)(ws + WS_MODP); float* MOD = (float*)(ws + WS_MOD);
    unsigned short* XS = (unsigned short*)(ws + WS_XS);     bf16* H = (bf16*)(ws + WS_H); bf16* ACT = (bf16*)(ws + WS_ACT); bf16* Yb = (bf16*)(ws + WS_Y); bf16* YP = (bf16*)(ws + WS_Y + 64 * MiB);
    bf16* YC = (bf16*)(ws + WS_YC); bf16* VC = (bf16*)(ws + WS_VC);
    bf16* Gb = ACT; bf16* Vb = ACT + (size_t)MALL * DM;
    bf16* ZT = ACT; bf16* Fb = ACT + (size_t)BATCH * DM * 4096; bf16* PB = (bf16*)(ws + WS_Y + 64 * MiB);
    const float* MOD0 = MOD; const float* MOD1 = MOD + 9 * NMOD;
#define NG(l, i) (norm_g + ((l) * 6 + (i)) * DM)
#define GREP1(...) __VA_ARGS__
#define GREP2(...) __VA_ARGS__ __VA_ARGS__
#if defined(PROBE_GEMM2)
#define GREP(...) GREP2(__VA_ARGS__)
#else
#define GREP(...) GREP1(__VA_ARGS__)
#endif
#if defined(PROBE_FFNIN2)
#define GREP_IN(...) GREP2(__VA_ARGS__)
#else
#define GREP_IN(...) GREP(__VA_ARGS__)
#endif
#if defined(PROBE_FFNOUT2)
#define GREP_OUT(...) GREP2(__VA_ARGS__)
#else
#define GREP_OUT(...) GREP(__VA_ARGS__)
#endif
    const int cid = (int)blockIdx.x;

    p0_adaln(F, c_in, cctx_in, mod_w, MODP);
    p0_quant_win(F, args.in[7], WinQ, SW);
    { WeightPtrs P{args.in[8], args.in[9], args.in[15], args.in[16], args.in[12], WoutT, WrinT, WroutT, WfouT, GW}; p0_weights(F, P); }
    p0_twiddles(F, T2, TW);
    GRID_BAR();
    p0_adaln_reduce(F, MODP, mod_b, MOD);
    thin_phase<false, true, true, false, false, true, false, true>(F, x_in, ctx_in, nullptr, nullptr, nullptr, H, SA, PAn, nullptr, nullptr, 0, 0.f, NG(0, 0), MOD0, 0, 1, MODP, mod_b);
    GRID_BAR();
    GREP({ pg8::Gemm g{H, (const bf16*)WinQ, DM / 2, DM / 2, DM / 2, 1, 0, 0, 0, 0}; pg8::BatchOrder S; S.init(MALL, 2 * DFF, 1, F.G, cid); pg8::EpiSwiGLU8 E{ACT, DFF, SA, SW};
      pg8::gemm_phase<pg8::EpiSwiGLU8, pg8::BatchOrder, true, true, true>(F.lds + RING_OFF, g, S, E, F.wave); })
    GRID_BAR();
    GREP_OUT({ pg8::Gemm g{ACT, WoutT, 64, 64, DFF, 1, 0, 0, 0, 0, 32768, (long)(DFF / 64) * 32768, 32768, (long)(DFF / 64) * 32768}; pg8::BatchOrder S; S.init(MLAT, DM, 1, F.G, cid); pg8::EpiBf16Z E{Yb, DM, 0, 1.0f};
      pg8::gemm_phase<pg8::EpiBf16Z, pg8::BatchOrder, true, true>(F.lds + RING_OFF, g, S, E, F.wave); })
    GREP({ pg8::Gemm g{ACT + (size_t)MLAT * DFF, WoutT, 64, 64, DFF / 4, 1, (long)(DFF / 4 / 64) * 32768, 0, (long)(DFF / 4 / 64) * 32768, 0, 32768, (long)(DFF / 64) * 32768, 32768, (long)(DFF / 64) * 32768}; pg8::BatchOrder S; S.init(MCTX, DM, 4, F.G, cid); pg8::EpiBf16Z E{YC, DM, MCTX, 1.0f};
      pg8::gemm_phase<pg8::EpiBf16Z, pg8::BatchOrder, true, true>(F.lds + RING_OFF, g, S, E, F.wave); })
    GRID_BAR();
    thin_phase<true, true, true, false, true, false>(F, x_in, ctx_in, Yb, YC, XS, H, SA, PAn, NG(0, 1), MOD0, 2, 0.5f, NG(0, 2), MOD0, 3, 4);
    GRID_BAR();
    GREP({ pg8::Gemm g{H, WrinT, DM, DM, DM, 1, 0, 0, 0, 0}; pg8::BatchOrder S; S.init(MLAT, 2 * DM, 1, F.G, cid); pg8::EpiGV E{Gb, Vb, args.in[10], args.in[11]};
      pg8::gemm_phase<pg8::EpiGV, pg8::BatchOrder, true, true>(F.lds + RING_OFF, g, S, E, F.wave); })
    GREP({ pg8::Gemm g{H + (size_t)MLAT * DM, WrinT + (size_t)DM * DM, DM, DM, DM / 4, 1, (DM / 4) * 2, 0, (DM / 4) * 2, 0}; pg8::BatchOrder S; S.init(MCTX, DM, 4, F.G, cid); pg8::EpiBf16Z E{VC, DM, MCTX, 1.0f};
      pg8::gemm_phase<pg8::EpiBf16Z, pg8::BatchOrder, true, true>(F.lds + RING_OFF, g, S, E, F.wave); })
    GRID_BAR();
    scan_phase(F, Vb, VC, Gb, YP, GW, args.in[10], args.in[11], args.in[13], args.in[14]);
    GRID_BAR();
    GREP({ pg8::Gemm g{Gb, WroutT, DM, DM, DM, 1, 0, 0, 0, 0}; pg8::BatchOrder S; S.init(MLAT, DM, 1, F.G, cid); pg8::EpiBf16Z E{Yb, DM, 0, 1.0f};
      pg8::gemm_phase<pg8::EpiBf16Z, pg8::BatchOrder, true, true>(F.lds + RING_OFF, g, S, E, F.wave); })
    GRID_BAR();
    thin_phase<true, true, false, true, true, true>(F, XS, nullptr, Yb, nullptr, XS, H, SA, PAn, NG(0, 3), MOD0, 5, 1.0f, NG(0, 4), MOD0, 6, 7);
    GRID_BAR();
#ifdef PROBE_CLK
    volatile LAS unsigned long long* PC = (volatile LAS unsigned long long*)(F.lds + MISC_OFF + 512);
    if (tid == 0) { PC[0] = (unsigned long long)clock64(); PC[1] = __builtin_amdgcn_s_memrealtime(); }
#endif
    GREP_IN({ pg8::Gemm g{H, (const bf16*)(WinQ + 1 * WIN_ELEMS), DM / 2, DM / 2, DM / 2, 1, 0, 0, 0, 0}; pg8::BatchOrder S; S.init(MLAT, 2 * DFF, 1, F.G, cid); pg8::EpiSwiGLU8 E{ACT, DFF, SA, SW + 1 * 2 * DFF};
      pg8::gemm_phase<pg8::EpiSwiGLU8, pg8::BatchOrder, true, true, true>(F.lds + RING_OFF, g, S, E, F.wave); })
#ifdef PROBE_CLK
    if (tid == 0) { PC[2] = (unsigned long long)clock64(); PC[3] = __builtin_amdgcn_s_memrealtime(); }
#endif
    GRID_BAR();
    GREP_OUT({ pg8::Gemm g{ACT, WoutT + WOUT_ELEMS, 64, 64, DFF, 1, 0, 0, 0, 0, 32768, (long)(DFF / 64) * 32768, 32768, (long)(DFF / 64) * 32768}; pg8::BatchOrder S; S.init(MLAT, DM, 1, F.G, cid); pg8::EpiBf16Z E{Yb, DM, 0, 1.0f};
      pg8::gemm_phase<pg8::EpiBf16Z, pg8::BatchOrder, true, true>(F.lds + RING_OFF, g, S, E, F.wave); })
    GRID_BAR();
    thin_phase<true, true, false, true, true, true>(F, XS, nullptr, Yb, nullptr, XS, H, SA, PAn, NG(0, 5), MOD0, 8, 0.5f, NG(1, 0), MOD1, 0, 1);
    GRID_BAR();
    GREP_IN({ pg8::Gemm g{H, (const bf16*)(WinQ + 2 * WIN_ELEMS), DM / 2, DM / 2, DM / 2, 1, 0, 0, 0, 0}; pg8::BatchOrder S; S.init(MLAT, 2 * DFF, 1, F.G, cid); pg8::EpiSwiGLU8 E{ACT, DFF, SA, SW + 2 * 2 * DFF};
      pg8::gemm_phase<pg8::EpiSwiGLU8, pg8::BatchOrder, true, true, true>(F.lds + RING_OFF, g, S, E, F.wave); })
    GRID_BAR();
    GREP_OUT({ pg8::Gemm g{ACT, WoutT + 2 * WOUT_ELEMS, 64, 64, DFF, 1, 0, 0, 0, 0, 32768, (long)(DFF / 64) * 32768, 32768, (long)(DFF / 64) * 32768}; pg8::BatchOrder S; S.init(MLAT, DM, 1, F.G, cid); pg8::EpiBf16Z E{Yb, DM, 0, 1.0f};
      pg8::gemm_phase<pg8::EpiBf16Z, pg8::BatchOrder, true, true>(F.lds + RING_OFF, g, S, E, F.wave); })
    GRID_BAR();
    thin_fold_phase(F, XS, Yb, H, PA, HN2, NG(1, 1), MOD1, 2, 0.5f, NG(1, 2), MOD1, 3, 4);
    GRID_BAR();
    for (int bid = (int)blockIdx.x; bid < 64; bid += F.G) {
        const int b = bid >> 3, g = bid & 7; LAS float* A = (LAS float*)F.lds; LAS float* A2 = A + 256; LAS float* CT = A + 512;
        const int tid = F.wave * 64 + lane_now();
        if (tid < 256) { float s = 0.f;
#pragma unroll 8
            for (int j = 0; j < 32; ++j) s += PA[(size_t)(b * 32 + j) * DM + g * 256 + tid];
            A[tid] = s; A2[tid] = HN2[(size_t)b * DM + g * 256 + tid]; CT[tid] = cospif((float)tid * (1.0f / 128.0f)); }
        __syncthreads();
        if (tid < 256) { float s = 0.f, s2 = 0.f;
            for (int c = 0; c < 256; ++c) { const float ct = CT[(tid * c) & 255]; s += ct * A[c]; s2 += ct * A2[c]; }
            Fb[((size_t)b * SEQ + 1024) * DM + g * 256 + tid] = (bf16)f2bf(s * (0.0625f * 0.02209708691207961f));
            EN2[(size_t)b * DM + g * 256 + tid] = s2 * 0.0625f; }
        __syncthreads();
    }
    GREP({ pg8::Gemm g{TW, H, 256, DM, 256, 8, 0, 0, (long)SEQ * DM * 2, 256 * 2}; pg8::ChOrder S; S.init(64, F.G, cid); pg8::EpiZT E{ZT};
      pg8::gemm_phase<pg8::EpiZT, pg8::ChOrder, true, true>(F.lds + RING_OFF, g, S, E, F.wave); })
    GRID_BAR();
    GREP({ pg8::Gemm g{T2, ZT, 2048, 2048, 1024, 1, 0, 0, (long)DM * 2048 * 2, 0}; pg8::BatchOrder S; S.init(1024, DM, 8, F.G, cid); pg8::EpiBf16Z E{PB, DM, 1024, 1.0f};
      pg8::gemm_phase<pg8::EpiBf16Z, pg8::BatchOrder, true, true>(F.lds + RING_OFF, g, S, E, F.wave); })
    VM_WAIT(); __syncthreads();
    GREP({ pg8::Gemm g{T2 + 1024, ZT + 1024, 2048, 2048, 1024, 1, 0, 0, (long)DM * 2048 * 2, 0}; pg8::BatchOrder S; S.init(1024, DM, 8, F.G, cid); pg8::EpiQ E{PB, Fb, EN2, 0.02209708691207961f};
      pg8::gemm_phase<pg8::EpiQ, pg8::BatchOrder, true, true>(F.lds + RING_OFF, g, S, E, F.wave); })
    GRID_BAR();
    GREP({ pg8::Gemm g{Fb, WfouT, DM, DM, DM, 1, 0, 0, 0, 0}; pg8::BatchOrder S; S.init(MLAT, DM, 1, F.G, cid); pg8::EpiBf16Z E{Yb, DM, 0, 1.0f};
      pg8::gemm_phase<pg8::EpiBf16Z, pg8::BatchOrder, true, true>(F.lds + RING_OFF, g, S, E, F.wave); })
    GRID_BAR();
    thin_phase<true, true, false, true, true, true>(F, XS, nullptr, Yb, nullptr, XS, H, SA, PAn, NG(1, 3), MOD1, 5, 1.0f, NG(1, 4), MOD1, 6, 7);
    GRID_BAR();
    GREP_IN({ pg8::Gemm g{H, (const bf16*)(WinQ + 3 * WIN_ELEMS), DM / 2, DM / 2, DM / 2, 1, 0, 0, 0, 0}; pg8::BatchOrder S; S.init(MLAT, 2 * DFF, 1, F.G, cid); pg8::EpiSwiGLU8 E{ACT, DFF, SA, SW + 3 * 2 * DFF};
      pg8::gemm_phase<pg8::EpiSwiGLU8, pg8::BatchOrder, true, true, true>(F.lds + RING_OFF, g, S, E, F.wave); })
    GRID_BAR();
    GREP_OUT({ pg8::Gemm g{ACT, WoutT + 3 * WOUT_ELEMS, 64, 64, DFF, 1, 0, 0, 0, 0, 32768, (long)(DFF / 64) * 32768, 32768, (long)(DFF / 64) * 32768}; pg8::BatchOrder S; S.init(MLAT, DM, 1, F.G, cid); pg8::EpiBf16Z E{Yb, DM, 0, 1.0f};
      pg8::gemm_phase<pg8::EpiBf16Z, pg8::BatchOrder, true, true>(F.lds + RING_OFF, g, S, E, F.wave); })
    GRID_BAR();
    thin_phase<true, false, false, true, false, false>(F, XS, nullptr, Yb, nullptr, args.out, nullptr, nullptr, nullptr, NG(1, 5), MOD1, 8, 0.5f, nullptr, nullptr, 0, 0);
#ifdef PROBE_TS
    GRID_BAR();
    if (blockIdx.x == 0 && tid == 0) {
        unsigned long long tot = 0;
        for (int i = 0; i < 23; ++i) if ((PROBE_MASK >> i) & 1u) tot += TS[i + 1] - TS[i];
#ifdef PROBE_MHZ_OF
        tot = ((TC[PROBE_MHZ_OF + 1] - TC[PROBE_MHZ_OF]) * 100ull / (TS[PROBE_MHZ_OF + 1] - TS[PROBE_MHZ_OF])) * 100ull;
#endif
        const unsigned long long t0 = __builtin_amdgcn_s_memrealtime();
        while (__builtin_amdgcn_s_memrealtime() - t0 < tot) __builtin_amdgcn_s_sleep(8);
    }
#endif
#ifdef PROBE_CLK
    if (blockIdx.x == 0 && tid == 0) {
        const unsigned long long dc = PC[2] - PC[0], dr = PC[3] - PC[1];
        const unsigned long long us = PROBE_CLK_WHAT == 0 ? (dc * 100ull) / (dr ? dr : 1ull) : dr / 100ull;
        const unsigned long long t0 = __builtin_amdgcn_s_memrealtime();
        while (__builtin_amdgcn_s_memrealtime() - t0 < us * 100ull) __builtin_amdgcn_s_sleep(8);
    }
#endif
#undef NG
#undef GRID_BAR
}

extern "C" void kernel_launch(void* const* d_in, const int* in_sizes, int n_in, void* d_out, int out_size, void* d_ws, size_t ws_size, hipStream_t stream) {
    static int grid = 0;
    if (grid == 0) {
        if (n_in != 17 || in_sizes[0] != MLAT * DM || out_size != MLAT * DM || ws_size < WS_END) {
            fprintf(stderr, "kernel_launch: unexpected problem (n_in %d, in0 %d, out %d, ws %zu; need ws >= %zu); nothing launched\n", n_in, n_in > 0 ? in_sizes[0] : -1, out_size, ws_size, (size_t)WS_END); grid = -1; return; }
        int dev = 0, cus = 0, per_cu = 0;
        if (hipGetDevice(&dev) != hipSuccess || hipDeviceGetAttribute(&cus, hipDeviceAttributeMultiprocessorCount, dev) != hipSuccess) { fprintf(stderr, "kernel_launch: device query failed\n"); grid = -1; return; }
        if (hipFuncSetAttribute((const void*)fwd_kernel, hipFuncAttributeMaxDynamicSharedMemorySize, LDS_BYTES) != hipSuccess) { fprintf(stderr, "kernel_launch: hipFuncSetAttribute failed\n"); grid = -1; return; }
        if (hipOccupancyMaxActiveBlocksPerMultiprocessor(&per_cu, (const void*)fwd_kernel, NWAVES * 64, LDS_BYTES) != hipSuccess || per_cu < 1)
            fprintf(stderr, "kernel_launch: note: occupancy query reports %d workgroups per CU\n", per_cu);
        (void)hipGetLastError();
        grid = cus < 256 ? cus : 256;
    }
    if (grid < 0) return;
    if (hipMemsetAsync((char*)d_ws + WS_CTL, 0, CTL_ZERO_BYTES, stream) != hipSuccess) { fprintf(stderr, "kernel_launch: hipMemsetAsync failed\n"); return; }
    Args a{};
    for (int i = 0; i < 17; ++i) a.in[i] = (const float*)d_in[i];
    a.out = (float*)d_out; a.ws = (unsigned char*)d_ws;
    hipLaunchKernelGGL(fwd_kernel, dim3(grid), dim3(NWAVES * 64), LDS_BYTES, stream, a);
    const hipError_t le = hipPeekAtLastError();
    if (le != hipSuccess) fprintf(stderr, "kernel_launch: launch failed: %s\n", hipGetErrorName(le));
}
```

```cpp
#include <hip/hip_runtime.h>
#include <cstdio>
#include <cstdint>

namespace pg8 {
#define PG8_LAS __attribute__((address_space(3)))
typedef unsigned short bf16_t;
typedef short bf16x8 __attribute__((ext_vector_type(8)));
typedef float f32x4 __attribute__((ext_vector_type(4)));
typedef unsigned u32x4 __attribute__((ext_vector_type(4)));
typedef int i32x4 __attribute__((ext_vector_type(4)));
constexpr int BM = 256, BK = 64, HALF = 128, HTB = HALF * BK * 2  , STAGE_BYTES = 8 * HTB, NXCD = 8, WGM = 8;

__host__ __device__ __forceinline__ int lds_byte(int r, int c) { const int st = (r >> 4) * 2 + (c >> 5), rr = r & 15, cc = c & 31, ob = rr * 64 + cc * 2; return st * 1024 + (ob ^ (((ob >> 9) & 1) << 5)); }
__host__ __device__ __forceinline__ void stage_rc(int b, int& R, int& C) { const int st = b / 1024, sb = b % 1024, swz = sb ^ (((sb >> 9) & 1) << 5); R = (st >> 1) * 16 + swz / 64; C = (st & 1) * 32 + (swz % 64) / 2; }
__host__ __device__ __forceinline__ int perm32(int rho) { const int n = rho >> 4, i = rho & 15; return 8 * (i >> 2) + 4 * n + (i & 3); }

struct Unit { int pm, pn, z; };
struct Gemm { const bf16_t* A; const bf16_t* Bt; int lda, ldb, K, zdiv; long a_s1, a_s0, b_s1, b_s0; long a_kstep = 0, a_tile = 0;
    __device__ __forceinline__ const char* baseA(const Unit& u) const { return (const char*)A + (long)(u.z / zdiv) * a_s1 + (long)(u.z % zdiv) * a_s0; }
    __device__ __forceinline__ const char* baseB(const Unit& u) const { return (const char*)Bt + (long)(u.z / zdiv) * b_s1 + (long)(u.z % zdiv) * b_s0; } };

struct BatchOrder {
    int nM, nN, per, nwg, G, c;
    __host__ __device__ void init(int M, int N, int nz, int G_, int c_) { nM = M / BM; nN = N / BM; per = nM * nN; nwg = per * nz; G = G_; c = c_; }
    __host__ __device__ bool next(int i, Unit& u) const {
        const long L = (long)i * G + c; if (L >= nwg) return false;
        int wgid = (int)L; { const int q = nwg / NXCD, r = nwg % NXCD, xcd = wgid % NXCD, off = wgid / NXCD; wgid = (xcd < r ? xcd * (q + 1) : r * (q + 1) + (xcd - r) * q) + off; }
        u.z = wgid / per; const int w = wgid % per;
        const int nig = WGM * nN, gid = w / nig, fm = gid * WGM, gsz = (nM - fm) < WGM ? (nM - fm) : WGM;
        u.pm = fm + ((w % nig) % gsz); u.pn = (w % nig) / gsz; return true;
    }
    __device__ __forceinline__ void a_ready(const Unit&) const {}
    __device__ __forceinline__ void done(const Unit&) const {}
};

struct ChOrder {
    int nwg, G, c;
    __host__ __device__ void init(int nz, int G_, int c_) { nwg = nz * 8; G = G_; c = c_; }
    __host__ __device__ bool next(int i, Unit& u) const {
        const long L = (long)i * G + c; if (L >= nwg) return false;
        int wgid = (int)L; { const int q = nwg / NXCD, r = nwg % NXCD, xcd = wgid % NXCD, off = wgid / NXCD; wgid = (xcd < r ? xcd * (q + 1) : r * (q + 1) + (xcd - r) * q) + off; }
        u.z = wgid >> 3; u.pn = wgid & 7; u.pm = u.pn >> 2; return true;
    }
    __device__ __forceinline__ void a_ready(const Unit&) const {}
    __device__ __forceinline__ void done(const Unit&) const {}
};

__device__ __forceinline__ unsigned cvt_pk_bf16(float lo, float hi) { unsigned r; asm volatile("v_cvt_pk_bf16_f32 %0, %1, %2" : "=v"(r) : "v"(lo), "v"(hi)); return r; }
__device__ __forceinline__ float sigmoid_f(float x) { return __builtin_amdgcn_rcpf(1.0f + __builtin_amdgcn_exp2f(-1.4426950408889634f * x)); }
__device__ __forceinline__ float gelu_tanh_f(float x) { return x * sigmoid_f(1.5957691216057308f * (x + 0.044715f * x * x * x)); }

struct EpiF32 {
    static constexpr bool PERM = false, AFTER_DRAIN = false;
    float* C; int ldc; long zs;
    __device__ __forceinline__ void operator()(const f32x4 (&acc)[2][2][4][2], const Unit& u, int wr, int wc, int fr, int fq) const {
        const int row0 = u.pm * BM + wr * 64 + fr, col0 = u.pn * BM + wc * 32 + 4 * fq;
#pragma unroll
        for (int ai = 0; ai < 2; ++ai)
#pragma unroll
            for (int m = 0; m < 4; ++m) { float* rowp = C + (size_t)u.z * zs + (size_t)(row0 + ai * HALF + m * 16) * ldc + col0;
#pragma unroll
                for (int bj = 0; bj < 2; ++bj)
#pragma unroll
                    for (int n = 0; n < 2; ++n) *(f32x4*)(rowp + bj * HALF + n * 16) = acc[ai][bj][m][n]; }
    }
};
struct EpiSwiGLU {
    static constexpr bool PERM = true, AFTER_DRAIN = false;
    bf16_t* O; int ldc;
    __device__ __forceinline__ void operator()(const f32x4 (&acc)[2][2][4][2], const Unit& u, int wr, int wc, int fr, int fq) const {
        const int row0 = u.pm * BM + wr * 64 + fr, col0 = u.pn * HALF + wc * 32 + 8 * fq;
#pragma unroll
        for (int ai = 0; ai < 2; ++ai)
#pragma unroll
            for (int m = 0; m < 4; ++m) { bf16_t* rowp = O + (size_t)(row0 + ai * HALF + m * 16) * ldc + col0;
                float o[8];
#pragma unroll
                for (int n = 0; n < 2; ++n)
#pragma unroll
                    for (int j = 0; j < 4; ++j) { const float gv = acc[ai][0][m][n][j], uv = acc[ai][1][m][n][j]; o[4 * n + j] = gv * sigmoid_f(gv) * uv; }
                u32x4 w; w.x = cvt_pk_bf16(o[0], o[1]); w.y = cvt_pk_bf16(o[2], o[3]); w.z = cvt_pk_bf16(o[4], o[5]); w.w = cvt_pk_bf16(o[6], o[7]);
                *(u32x4*)rowp = w; }
    }
};
struct EpiSwiGLU8 {
    static constexpr bool PERM = true, AFTER_DRAIN = false;
    bf16_t* O; int ldc; const float* sa; const float* sw;
    typedef float f32x2 __attribute__((ext_vector_type(2)));
    __device__ __forceinline__ void operator()(const f32x4 (&acc)[2][2][4][2], const Unit& u, int wr, int wc, int fr, int fq) const {
        const int row0 = u.pm * BM + wr * 64 + fr, col0 = u.pn * HALF + wc * 32 + 8 * fq, wrow0 = u.pn * BM + wc * 32 + 8 * fq;
        f32x4 sg[2], su[2]; float sr[2][4];
#pragma unroll
        for (int n = 0; n < 2; ++n) { sg[n] = *(const f32x4*)(sw + wrow0 + 4 * n); su[n] = *(const f32x4*)(sw + wrow0 + HALF + 4 * n); }
#pragma unroll
        for (int ai = 0; ai < 2; ++ai)
#pragma unroll
            for (int m = 0; m < 4; ++m) sr[ai][m] = sa[row0 + ai * HALF + m * 16];
        f32x2 sgn[4], sgu[4];
#pragma unroll
        for (int p = 0; p < 4; ++p) { const int n = p >> 1, h = 2 * (p & 1); const f32x2 g2 = (f32x2){sg[n][h], sg[n][h + 1]}, u2 = (f32x2){su[n][h], su[n][h + 1]};
            sgn[p] = g2 * -1.4426950408889634f; sgu[p] = g2 * u2; }
#pragma unroll
        for (int ai = 0; ai < 2; ++ai)
#pragma unroll
            for (int m = 0; m < 4; ++m) { const int r = row0 + ai * HALF + m * 16; const float s = sr[ai][m], s2 = s * s; bf16_t* rowp = O + ((((size_t)(r >> 8) * (5632 / 64) + (col0 >> 6)) * 256 + (r & 255)) << 6) + (col0 & 63);
                unsigned wv[4];
#pragma unroll
                for (int p = 0; p < 4; ++p) { const int n = p >> 1, h = 2 * (p & 1);
                    const float g0 = acc[ai][0][m][n][h], g1 = acc[ai][0][m][n][h + 1], u0 = acc[ai][1][m][n][h], u1 = acc[ai][1][m][n][h + 1];
                    const f32x2 gf = (f32x2){(float)__float_as_int(g0), (float)__float_as_int(g1)}, uf = (f32x2){(float)__float_as_int(u0), (float)__float_as_int(u1)};
                    const f32x2 arg = gf * (sgn[p] * s);
                    const f32x2 d = (f32x2){__builtin_amdgcn_exp2f(arg.x), __builtin_amdgcn_exp2f(arg.y)} + 1.0f;
                    const f32x2 rc = (f32x2){__builtin_amdgcn_rcpf(d.x), __builtin_amdgcn_rcpf(d.y)};
                    const f32x2 o = (gf * uf) * ((sgu[p] * s2) * rc);
                    wv[p] = cvt_pk_bf16(o.x, o.y); }
                u32x4 w; w.x = wv[0]; w.y = wv[1]; w.z = wv[2]; w.w = wv[3];
                *(u32x4*)rowp = w; }
    }
};
struct EpiGV {
    static constexpr bool PERM = true, AFTER_DRAIN = false;
    bf16_t* G; bf16_t* V; const float* cw; const float* cb;
    __device__ __forceinline__ void operator()(const f32x4 (&acc)[2][2][4][2], const Unit& u, int wr, int wc, int fr, int fq) const {
        const bool isg = u.pn < 8; bf16_t* base = isg ? G : V;
        const int row0 = u.pm * BM + wr * 64 + fr, col0 = (isg ? u.pn : u.pn - 8) * BM + wc * 32 + 8 * fq;
        if (isg) {
#pragma unroll
            for (int ai = 0; ai < 2; ++ai)
#pragma unroll
                for (int m = 0; m < 4; ++m) { bf16_t* rowp = base + (size_t)(row0 + ai * HALF + m * 16) * 2048 + col0;
#pragma unroll
                    for (int bj = 0; bj < 2; ++bj) { f32x4 v0 = acc[ai][bj][m][0], v1 = acc[ai][bj][m][1];
#pragma unroll
                        for (int j = 0; j < 4; ++j) { v0[j] = gelu_tanh_f(v0[j]); v1[j] = gelu_tanh_f(v1[j]); }
                        u32x4 w; w.x = cvt_pk_bf16(v0[0], v0[1]); w.y = cvt_pk_bf16(v0[2], v0[3]); w.z = cvt_pk_bf16(v1[0], v1[1]); w.w = cvt_pk_bf16(v1[2], v1[3]);
                        *(u32x4*)(rowp + bj * HALF) = w; } }
        } else {
#pragma unroll
            for (int bj = 0; bj < 2; ++bj) {
                f32x4 w[4][2], bb[2];
#pragma unroll
                for (int n = 0; n < 2; ++n) { bb[n] = *(const f32x4*)(cb + col0 + bj * HALF + 4 * n);
#pragma unroll
                    for (int k = 0; k < 4; ++k) w[k][n] = *(const f32x4*)(cw + k * 2048 + col0 + bj * HALF + 4 * n); }
#pragma unroll
                for (int ai = 0; ai < 2; ++ai) {
                    f32x4 o[4][2];
#pragma unroll
                    for (int n = 0; n < 2; ++n)
#pragma unroll
                        for (int j = 0; j < 4; ++j) {
                            float r1[4], r2[4], f1[4];
#pragma unroll
                            for (int m = 0; m < 4; ++m) { const int xi = __float_as_int(acc[ai][bj][m][n][j]);
                                r1[m] = __int_as_float(__builtin_amdgcn_update_dpp(0, xi, 0x121, 0xf, 0xf, false));
                                r2[m] = __int_as_float(__builtin_amdgcn_update_dpp(0, xi, 0x122, 0xf, 0xf, false));
                                f1[m] = __int_as_float(__builtin_amdgcn_update_dpp(0, xi, 0x12f, 0xf, 0xf, false)); }
#pragma unroll
                            for (int m = 0; m < 4; ++m) {
                                const float xm1 = fr >= 1 ? r1[m] : (m > 0 ? r1[m > 0 ? m - 1 : 0] : 0.f);
                                const float xm2 = fr >= 2 ? r2[m] : (m > 0 ? r2[m > 0 ? m - 1 : 0] : 0.f);
                                const float xp1 = fr <= 14 ? f1[m] : (m < 3 ? f1[m < 3 ? m + 1 : 3] : 0.f);
                                o[m][n][j] = bb[n][j] + w[0][n][j] * xm2 + w[1][n][j] * xm1 + w[2][n][j] * acc[ai][bj][m][n][j] + w[3][n][j] * xp1; }
                        }
#pragma unroll
                    for (int m = 0; m < 4; ++m) { bf16_t* rowp = base + (size_t)(row0 + ai * HALF + m * 16) * 2048 + col0 + bj * HALF;
                        u32x4 wv; wv.x = cvt_pk_bf16(o[m][0][0], o[m][0][1]); wv.y = cvt_pk_bf16(o[m][0][2], o[m][0][3]); wv.z = cvt_pk_bf16(o[m][1][0], o[m][1][1]); wv.w = cvt_pk_bf16(o[m][1][2], o[m][1][3]);
                        *(u32x4*)rowp = wv; }
                }
            }
        }
    }
};
struct EpiBf16Z {
    static constexpr bool PERM = true, AFTER_DRAIN = false;
    bf16_t* O; int ldc; int roff_z; float scale;
    __device__ __forceinline__ void operator()(const f32x4 (&acc)[2][2][4][2], const Unit& u, int wr, int wc, int fr, int fq) const {
        const int row0 = u.z * roff_z + u.pm * BM + wr * 64 + fr, col0 = u.pn * BM + wc * 32 + 8 * fq;
#pragma unroll
        for (int ai = 0; ai < 2; ++ai)
#pragma unroll
            for (int m = 0; m < 4; ++m) { bf16_t* rowp = O + (size_t)(row0 + ai * HALF + m * 16) * ldc + col0;
#pragma unroll
                for (int bj = 0; bj < 2; ++bj) { const f32x4 v0 = acc[ai][bj][m][0] * scale, v1 = acc[ai][bj][m][1] * scale;
                    u32x4 w; w.x = cvt_pk_bf16(v0[0], v0[1]); w.y = cvt_pk_bf16(v0[2], v0[3]); w.z = cvt_pk_bf16(v1[0], v1[1]); w.w = cvt_pk_bf16(v1[2], v1[3]);
                    *(u32x4*)(rowp + bj * HALF) = w; } }
    }
};
struct EpiQ {
    static constexpr bool PERM = true, AFTER_DRAIN = false;
    const bf16_t* PB; bf16_t* Fo; const float* En; float scale;
    __device__ __forceinline__ void operator()(const f32x4 (&acc)[2][2][4][2], const Unit& u, int wr, int wc, int fr, int fq) const {
        const int k0 = u.pm * BM + wr * 64 + fr, col0 = u.pn * BM + wc * 32 + 8 * fq;
        float se[2][8];
        { const float sg = (fr & 1) ? -1.0f : 1.0f;
#pragma unroll
          for (int bj = 0; bj < 2; ++bj) { const f32x4 e0 = *(const f32x4*)(En + (size_t)u.z * 2048 + col0 + bj * HALF), e1 = *(const f32x4*)(En + (size_t)u.z * 2048 + col0 + bj * HALF + 4);
              se[bj][0] = sg * e0[0]; se[bj][1] = sg * e0[1]; se[bj][2] = sg * e0[2]; se[bj][3] = sg * e0[3]; se[bj][4] = sg * e1[0]; se[bj][5] = sg * e1[1]; se[bj][6] = sg * e1[2]; se[bj][7] = sg * e1[3]; } }
#pragma unroll
        for (int ai = 0; ai < 2; ++ai) {
            u32x4 pwv[4][2];
#pragma unroll
            for (int m = 0; m < 4; ++m) { const bf16_t* prow = PB + ((size_t)u.z * 1024 + (k0 + ai * HALF + m * 16)) * 2048 + col0;
                pwv[m][0] = *(const u32x4*)prow; pwv[m][1] = *(const u32x4*)(prow + HALF); }
#pragma unroll
            for (int m = 0; m < 4; ++m) { const int k = k0 + ai * HALF + m * 16;
                bf16_t* frow = Fo + ((size_t)u.z * 2048 + k) * 2048 + col0; bf16_t* mrow = Fo + ((size_t)u.z * 2048 + (2048 - k)) * 2048 + col0;
#pragma unroll
                for (int bj = 0; bj < 2; ++bj) { const u32x4 pw = pwv[m][bj]; const f32x4 q0 = acc[ai][bj][m][0], q1 = acc[ai][bj][m][1];
                    const float p[8] = {__uint_as_float(pw.x << 16) + se[bj][0], __uint_as_float(pw.x & 0xffff0000u) + se[bj][1], __uint_as_float(pw.y << 16) + se[bj][2], __uint_as_float(pw.y & 0xffff0000u) + se[bj][3],
                                        __uint_as_float(pw.z << 16) + se[bj][4], __uint_as_float(pw.z & 0xffff0000u) + se[bj][5], __uint_as_float(pw.w << 16) + se[bj][6], __uint_as_float(pw.w & 0xffff0000u) + se[bj][7]};
                    const float q[8] = {q0[0], q0[1], q0[2], q0[3], q1[0], q1[1], q1[2], q1[3]};
                    u32x4 wp, wm;
                    wp.x = cvt_pk_bf16((p[0] + q[0]) * scale, (p[1] + q[1]) * scale); wp.y = cvt_pk_bf16((p[2] + q[2]) * scale, (p[3] + q[3]) * scale);
                    wp.z = cvt_pk_bf16((p[4] + q[4]) * scale, (p[5] + q[5]) * scale); wp.w = cvt_pk_bf16((p[6] + q[6]) * scale, (p[7] + q[7]) * scale);
                    wm.x = cvt_pk_bf16((p[0] - q[0]) * scale, (p[1] - q[1]) * scale); wm.y = cvt_pk_bf16((p[2] - q[2]) * scale, (p[3] - q[3]) * scale);
                    wm.z = cvt_pk_bf16((p[4] - q[4]) * scale, (p[5] - q[5]) * scale); wm.w = cvt_pk_bf16((p[6] - q[6]) * scale, (p[7] - q[7]) * scale);
                    *(u32x4*)(frow + bj * HALF) = wp;
                    if (k > 0) *(u32x4*)(mrow + bj * HALF) = wm; } } }
    }
};
struct EpiZT {
    static constexpr bool PERM = true, AFTER_DRAIN = false;
    bf16_t* ZT;
    __device__ __forceinline__ void operator()(const f32x4 (&acc)[2][2][4][2], const Unit& u, int wr, int wc, int fr, int fq) const {
        const int b = u.z >> 3, g = u.z & 7;
        bf16_t* base = ZT + ((size_t)b * 2048 + (size_t)g * 256) * 2048;
        const int row0 = wr * 64 + fr, col0 = u.pn * BM + wc * 32 + 8 * fq;
#pragma unroll
        for (int ai = 0; ai < 2; ++ai)
#pragma unroll
            for (int m = 0; m < 4; ++m) { bf16_t* rowp = base + (size_t)(row0 + ai * HALF + m * 16) * 2048 + col0;
#pragma unroll
                for (int bj = 0; bj < 2; ++bj) { const f32x4 v0 = acc[ai][bj][m][0] * 0.0625f, v1 = acc[ai][bj][m][1] * 0.0625f;
                    u32x4 w; w.x = cvt_pk_bf16(v0[0], v0[1]); w.y = cvt_pk_bf16(v0[2], v0[3]); w.z = cvt_pk_bf16(v1[0], v1[1]); w.w = cvt_pk_bf16(v1[2], v1[3]);
                    *(u32x4*)(rowp + bj * HALF) = w; } }
    }
};

template <class Epi, class Sched, bool ALIGN_EPI = false, bool SP2 = false, bool I8 = false>
__device__ __forceinline__ void gemm_phase(PG8_LAS unsigned char* lds, const Gemm g, const Sched& S, const Epi& E, const int wave) {
    int tid_; asm volatile("v_mbcnt_lo_u32_b32 %0, -1, 0\n\tv_mbcnt_hi_u32_b32 %0, -1, %0" : "=v"(tid_)); tid_ += wave * 64;
    const int tid = tid_, wid = wave, lane = tid & 63, wr = wid >> 2, wc = wid & 3, fr = lane & 15, fq = lane >> 4;
    const int K = g.K, nt = K / BK;
    unsigned voffA[2], voffB[2];
#pragma unroll
    for (int i = 0; i < 2; ++i) { int R, C; stage_rc(tid * 16 + i * 8192, R, C); const int Rb = Epi::PERM ? ((R & ~31) + perm32(R & 31)) : R;
        voffA[i] = (unsigned)(R * g.lda + C) * 2u; voffB[i] = (unsigned)(Rb * g.ldb + C) * 2u; }
    const size_t kstep = (size_t)(BK * 2);
    const size_t kstepA = g.a_kstep ? (size_t)g.a_kstep : kstep;
    const size_t hA = (size_t)HALF * g.lda * 2, hB = (size_t)HALF * g.ldb * 2;
    const size_t tA = g.a_tile ? (size_t)g.a_tile : 2 * hA, tB = 2 * hB;
    const unsigned ldsw = (unsigned)wid * 1024u;
    const int aoff = lds_byte(wr * 64 + fr, fq * 8), boff = lds_byte(wc * 32 + fr, fq * 8);
#define PG8_SA(b, h) (((b) * 2 + (h)) * HTB)
#define PG8_SB(b, h) ((4 + (b) * 2 + (h)) * HTB)
#define PG8_STAGE(bufoff, gbase, voff) do { _Pragma("unroll") for (int _i = 0; _i < 2; ++_i) \
        __builtin_amdgcn_global_load_lds((const unsigned*)((const char*)(gbase) + (voff)[_i]), (PG8_LAS unsigned*)(lds + (bufoff) + ldsw + _i * 8192), 16, 0, 0); } while (0)
#define PG8_LDA(dst, b, h) do { _Pragma("unroll") for (int m = 0; m < 4; ++m) _Pragma("unroll") for (int k = 0; k < 2; ++k) dst[m][k] = *(const PG8_LAS bf16x8*)(lds + PG8_SA(b, h) + aoff + m * 2048 + k * 1024); } while (0)
#define PG8_LDB(dst, b, h) do { _Pragma("unroll") for (int n = 0; n < 2; ++n) _Pragma("unroll") for (int k = 0; k < 2; ++k) dst[n][k] = *(const PG8_LAS bf16x8*)(lds + PG8_SB(b, h) + boff + n * 2048 + k * 1024); } while (0)
#define PG8_MMA(ai, bj, At, Bt) do { __builtin_amdgcn_s_setprio(1); _Pragma("unroll") for (int m = 0; m < 4; ++m) _Pragma("unroll") for (int n = 0; n < 2; ++n) _Pragma("unroll") for (int k = 0; k < 2; ++k) \
        { if constexpr (I8) acc[ai][bj][m][n] = __builtin_bit_cast(f32x4, __builtin_amdgcn_mfma_i32_16x16x64_i8(__builtin_bit_cast(i32x4, Bt[n][k]), __builtin_bit_cast(i32x4, At[m][k]), __builtin_bit_cast(i32x4, acc[ai][bj][m][n]), 0, 0, 0)); \
          else acc[ai][bj][m][n] = __builtin_amdgcn_mfma_f32_16x16x32_bf16(Bt[n][k], At[m][k], acc[ai][bj][m][n], 0, 0, 0); } __builtin_amdgcn_s_setprio(0); } while (0)
#define PG8_WAIT_V(n) asm volatile("s_waitcnt vmcnt(" #n ")" ::: "memory")
#define PG8_WAIT_L(n) asm volatile("s_waitcnt lgkmcnt(" #n ")" ::: "memory")
#define PG8_BAR __builtin_amdgcn_s_barrier()
#define PG8_SCHED __builtin_amdgcn_sched_barrier(0)
    Unit cur, nxt; int ui = 0;
    if (!S.next(0, cur)) return;
    f32x4 acc[2][2][4][2];
#pragma unroll
    for (int a = 0; a < 2; ++a)
#pragma unroll
        for (int b = 0; b < 2; ++b)
#pragma unroll
            for (int m = 0; m < 4; ++m)
#pragma unroll
                for (int n = 0; n < 2; ++n) acc[a][b][m][n] = (f32x4){0.f, 0.f, 0.f, 0.f};
    bf16x8 At[4][2], B0[2][2], B1[2][2];
    const char* cA = g.baseA(cur) + (size_t)cur.pm * tA; const char* cB = g.baseB(cur) + (size_t)cur.pn * tB;
    S.a_ready(cur);
    if constexpr (SP2) {
        PG8_STAGE(PG8_SB(0, 0), cB, voffB); PG8_STAGE(PG8_SB(0, 1), cB + hB, voffB); PG8_STAGE(PG8_SA(0, 0), cA, voffA); PG8_STAGE(PG8_SA(0, 1), cA + hA, voffA);
        if (wr == 1) PG8_BAR;
        PG8_WAIT_V(2); PG8_BAR;
        PG8_STAGE(PG8_SB(1, 0), cB + kstep, voffB); PG8_STAGE(PG8_SA(1, 0), cA + kstepA, voffA); PG8_STAGE(PG8_SB(1, 1), cB + hB + kstep, voffB);
        PG8_WAIT_V(6); PG8_BAR;
    } else {
        PG8_STAGE(PG8_SB(0, 0), cB, voffB); PG8_STAGE(PG8_SA(0, 0), cA, voffA); PG8_STAGE(PG8_SB(0, 1), cB + hB, voffB); PG8_STAGE(PG8_SA(0, 1), cA + hA, voffA);
        if (wr == 1) PG8_BAR;
        PG8_WAIT_V(4); PG8_BAR;
        PG8_STAGE(PG8_SB(1, 0), cB + kstep, voffB); PG8_STAGE(PG8_SA(1, 0), cA + kstepA, voffA); PG8_STAGE(PG8_SB(1, 1), cB + hB + kstep, voffB);
        PG8_WAIT_V(6); PG8_BAR;
    }
    for (;;) {
        const bool has_next = S.next(ui + 1, nxt);
        const char* nA = has_next ? g.baseA(nxt) + (size_t)nxt.pm * tA : cA; const char* nB = has_next ? g.baseB(nxt) + (size_t)nxt.pn * tB : cB;
        for (int t = 0; t < nt; t += 2) {
            const bool last = (t == nt - 2);
            const char* a1 = cA + (size_t)(t + 1) * kstepA;
            const char* a2 = last ? nA : cA + (size_t)(t + 2) * kstepA; const char* b2 = last ? nB : cB + (size_t)(t + 2) * kstep;
            const char* a3 = a2 + kstepA; const char* b3 = b2 + kstep;
            if (last && has_next) S.a_ready(nxt);
            if constexpr (SP2) {
            PG8_LDB(B0, 0, 0); PG8_LDB(B1, 0, 1); PG8_SCHED; PG8_LDA(At, 0, 0); PG8_STAGE(PG8_SA(1, 1), a1 + hA, voffA);
            PG8_WAIT_V(8); PG8_WAIT_L(0); PG8_BAR; PG8_MMA(0, 0, At, B0); PG8_MMA(0, 1, At, B1); PG8_BAR; PG8_SCHED;
            PG8_LDA(At, 0, 1); PG8_STAGE(PG8_SB(0, 0), b2, voffB); PG8_STAGE(PG8_SB(0, 1), b2 + hB, voffB); PG8_STAGE(PG8_SA(0, 0), a2, voffA);
            PG8_WAIT_V(8); PG8_WAIT_L(0); PG8_BAR; PG8_MMA(1, 0, At, B0); PG8_MMA(1, 1, At, B1); PG8_BAR; PG8_SCHED;
            PG8_LDB(B0, 1, 0); PG8_LDB(B1, 1, 1); PG8_SCHED; PG8_LDA(At, 1, 0); PG8_STAGE(PG8_SA(0, 1), a2 + hA, voffA);
            PG8_WAIT_V(8); PG8_WAIT_L(0); PG8_BAR; PG8_MMA(0, 0, At, B0); PG8_MMA(0, 1, At, B1); PG8_BAR; PG8_SCHED;
            PG8_LDA(At, 1, 1); PG8_STAGE(PG8_SB(1, 0), b3, voffB); PG8_STAGE(PG8_SB(1, 1), b3 + hB, voffB); PG8_STAGE(PG8_SA(1, 0), a3, voffA);
            PG8_WAIT_V(8); PG8_WAIT_L(0); PG8_BAR; PG8_MMA(1, 0, At, B0); PG8_MMA(1, 1, At, B1); PG8_BAR; PG8_SCHED;
            } else {
            PG8_LDB(B0, 0, 0); PG8_SCHED; PG8_LDA(At, 0, 0); PG8_STAGE(PG8_SA(1, 1), a1 + hA, voffA);
            PG8_WAIT_L(8); PG8_BAR; PG8_WAIT_L(0); PG8_MMA(0, 0, At, B0); PG8_BAR; PG8_SCHED;
            PG8_LDB(B1, 0, 1); PG8_STAGE(PG8_SB(0, 0), b2, voffB);
            PG8_BAR; PG8_WAIT_L(0); PG8_MMA(0, 1, At, B1); PG8_BAR;
            PG8_LDA(At, 0, 1); PG8_STAGE(PG8_SA(0, 0), a2, voffA);
            PG8_BAR; PG8_WAIT_L(0); PG8_MMA(1, 0, At, B0); PG8_BAR; PG8_SCHED;
            PG8_STAGE(PG8_SB(0, 1), b2 + hB, voffB);
            PG8_WAIT_V(6); PG8_BAR; PG8_MMA(1, 1, At, B1); PG8_BAR;
            PG8_LDB(B0, 1, 0); PG8_SCHED; PG8_LDA(At, 1, 0); PG8_STAGE(PG8_SA(0, 1), a2 + hA, voffA);
            PG8_WAIT_L(8); PG8_BAR; PG8_WAIT_L(0); PG8_MMA(0, 0, At, B0); PG8_BAR; PG8_SCHED;
            PG8_LDB(B1, 1, 1); PG8_STAGE(PG8_SB(1, 0), b3, voffB);
            PG8_BAR; PG8_WAIT_L(0); PG8_MMA(0, 1, At, B1); PG8_BAR;
            PG8_LDA(At, 1, 1); PG8_STAGE(PG8_SA(1, 0), a3, voffA);
            PG8_BAR; PG8_WAIT_L(0); PG8_MMA(1, 0, At, B0); PG8_BAR; PG8_SCHED;
            PG8_STAGE(PG8_SB(1, 1), b3 + hB, voffB);
            PG8_WAIT_V(6); PG8_BAR; PG8_MMA(1, 1, At, B1); PG8_BAR;
            }
        }
        if constexpr (ALIGN_EPI) { if (wr == 0) PG8_BAR; }
        if constexpr (!Epi::AFTER_DRAIN) { E(acc, cur, wr, wc, fr, fq); S.done(cur); }
        if (!has_next) break;
#pragma unroll
        for (int a = 0; a < 2; ++a)
#pragma unroll
            for (int b = 0; b < 2; ++b)
#pragma unroll
                for (int m = 0; m < 4; ++m)
#pragma unroll
                    for (int n = 0; n < 2; ++n) acc[a][b][m][n] = (f32x4){0.f, 0.f, 0.f, 0.f};
        cur = nxt; cA = nA; cB = nB; ++ui;
        if constexpr (ALIGN_EPI) { if (wr == 1) PG8_BAR; }
    }
    PG8_WAIT_V(0);
    if constexpr (!ALIGN_EPI) { if (wr == 0) PG8_BAR; }
    PG8_BAR;
    if constexpr (Epi::AFTER_DRAIN) { E.fused(acc, cur, wr, wc, fr, fq, lds, wid, lane); S.done(cur); }
#undef PG8_SA
#undef PG8_SB
#undef PG8_STAGE
#undef PG8_LDA
#undef PG8_LDB
#undef PG8_MMA
#undef PG8_WAIT_V
#undef PG8_WAIT_L
#undef PG8_BAR
#undef PG8_SCHED
}
}

constexpr int NWAVES = 8;
constexpr int DM = 2048, BATCH = 8, SEQ = 2048, CTXL = 256, DFF = 5632, NMOD = 9 * DM;
constexpr int MLAT = BATCH * SEQ, MCTX = BATCH * CTXL, MALL = MLAT + MCTX;
constexpr float EPS = 1e-6f;

constexpr size_t MiB = 1u << 20;
constexpr size_t WS_CTL = 0, CTL_ZERO_BYTES = 1 * MiB;
constexpr size_t WS_WIN = 1 * MiB;
constexpr size_t WS_WOUT = 177 * MiB;
constexpr size_t WS_WRIN = 265 * MiB;
constexpr size_t WS_WROUT = 281 * MiB;
constexpr size_t WS_WFOU = 289 * MiB;
constexpr size_t WS_GW = 297 * MiB;
constexpr size_t WS_T2 = 299 * MiB;
constexpr size_t WS_TW = 315 * MiB;
constexpr size_t WS_MOD = 322 * MiB;
constexpr size_t WS_XS = 324 * MiB;
constexpr size_t WS_H = 468 * MiB;
constexpr size_t WS_ACT = 540 * MiB;
constexpr size_t WS_Y = 738 * MiB;
constexpr size_t WS_MODP = 882 * MiB;
constexpr size_t WS_YC = 894 * MiB;
constexpr size_t WS_VC = 958 * MiB;
constexpr size_t WS_SW = 1022 * MiB;
constexpr size_t WS_SA = 1023 * MiB;
constexpr size_t WS_PA = 1024 * MiB;
constexpr size_t WS_HN2 = 1026 * MiB;
constexpr size_t WS_EN2 = WS_HN2 + 65536;
constexpr size_t WS_END = 1027 * MiB;
constexpr size_t CSL = (size_t)MCTX * DM;
constexpr size_t WIN_ELEMS = (size_t)2 * DFF * DM, WOUT_ELEMS = (size_t)DM * DFF;
constexpr int CW_BAR = 4096;

constexpr int RING_OFF = 0, RING_BYTES = 131072;
constexpr int LDSCTL_OFF = 143360, MISC_OFF = LDSCTL_OFF + 320;
constexpr int LDS_BYTES = 147456;

#define GAS __attribute__((address_space(1)))
#define LAS __attribute__((address_space(3)))
typedef unsigned short bf16;
typedef unsigned v4u __attribute__((ext_vector_type(4)));
typedef unsigned v2u __attribute__((ext_vector_type(2)));
typedef float f32x4 __attribute__((ext_vector_type(4)));
typedef short bf16x8 __attribute__((ext_vector_type(8)));
typedef GAS unsigned gu32;
#define RLX_AGENT __ATOMIC_RELAXED, __HIP_MEMORY_SCOPE_AGENT
#define LDS_WAIT() asm volatile("s_waitcnt lgkmcnt(0)" ::: "memory")
#define VM_WAIT() asm volatile("s_waitcnt vmcnt(0)" ::: "memory")
__device__ __forceinline__ unsigned f2bf(float f) { unsigned u = __builtin_bit_cast(unsigned, f); return (u + 0x7fffu + ((u >> 16) & 1u)) >> 16; }
__device__ __forceinline__ unsigned pk2(float lo, float hi) { return pg8::cvt_pk_bf16(lo, hi); }
typedef _Float16 h16x2 __attribute__((ext_vector_type(2)));
__device__ __forceinline__ unsigned pkh2(float lo, float hi) { h16x2 v; v.x = (_Float16)lo; v.y = (_Float16)hi; return __builtin_bit_cast(unsigned, v); }
__device__ __forceinline__ float h_lo(unsigned w) { return (float)__builtin_bit_cast(h16x2, w).x; }
__device__ __forceinline__ float h_hi(unsigned w) { return (float)__builtin_bit_cast(h16x2, w).y; }
__device__ __forceinline__ float bf_lo(unsigned w) { return __uint_as_float(w << 16); }
__device__ __forceinline__ float bf_hi(unsigned w) { return __uint_as_float(w & 0xffff0000u); }

__device__ __forceinline__ int lane_now() { int l; asm volatile("v_mbcnt_lo_u32_b32 %0, -1, 0\n\tv_mbcnt_hi_u32_b32 %0, -1, %0" : "=v"(l)); return l; }
#define XB_TMO      128
#define XB_XCNT(j)  (256  + 64 * (j))
#define XB_XSUB(j)  (1280 + 64 * (j))
#define XB_XGEN(j)  (2304 + 64 * (j))
#define XB_TOP      3328
#define XB_TOPGEN   3392
#define XCD_BAR_WORDS 3456
#define XB_SPIN_CAP (1u << 18)

__device__ __forceinline__ unsigned xb_ld(unsigned* p)              { return __hip_atomic_load(p, __ATOMIC_RELAXED, __HIP_MEMORY_SCOPE_AGENT); }
__device__ __forceinline__ unsigned xb_add(unsigned* p, unsigned v) { return __hip_atomic_fetch_add(p, v, __ATOMIC_RELAXED, __HIP_MEMORY_SCOPE_AGENT); }
__device__ __forceinline__ unsigned xb_xcc_id() { return (unsigned)__builtin_amdgcn_s_getreg((3 << 11) | 20) & 0xFu; }
#define XB_SPIN(cond, bar) do { unsigned _sp = 0; while (cond) { __builtin_amdgcn_s_sleep(1); \
    if ((++_sp & 255u) == 0u) { if (xb_ld(&(bar)[XB_TMO])) break; if (_sp > XB_SPIN_CAP) { atomicAdd(&(bar)[XB_TMO], 1u); break; } } } } while (0)

struct XcdBarrier {
    unsigned* bar; unsigned x; int wave;
    volatile LAS unsigned* st;
};
__device__ __forceinline__ XcdBarrier xcd_barrier_post(unsigned* bar, volatile LAS unsigned* st, int wave) {
    XcdBarrier b; b.bar = bar; b.x = xb_xcc_id(); b.st = st; b.wave = wave;
    if (wave == 0 && lane_now() == 0) (void)xb_add(&bar[XB_XCNT(b.x)], 1u);
    return b;
}
__device__ __forceinline__ void xcd_barrier_complete(unsigned* bar, unsigned x, unsigned& nloc, unsigned& nx) {
    const unsigned G = gridDim.x * gridDim.y * gridDim.z;
    unsigned sum, cnt, mine, sp = 0u;
    for (;;) {
        sum = 0u; cnt = 0u; mine = 0u;
#pragma unroll
        for (unsigned j = 0; j < 16; ++j) { const unsigned c = xb_ld(&bar[XB_XCNT(j)]); sum += c; cnt += (c > 0u) ? 1u : 0u; mine = (j == x) ? c : mine; }
        if (sum == G) break;
        __builtin_amdgcn_s_sleep(1);
        if ((++sp & 255u) == 0u) { if (xb_ld(&bar[XB_TMO])) break; if (sp > XB_SPIN_CAP) { atomicAdd(&bar[XB_TMO], 1u); break; } }
    }
    nloc = mine > 0u ? mine : 1u; nx = cnt > 0u ? cnt : 1u;
}
__device__ __forceinline__ void xcd_barrier(const XcdBarrier& b) {
    asm volatile("s_waitcnt vmcnt(0)" ::: "memory");
    __syncthreads();
    if (b.wave == 0 && lane_now() == 0) {
        unsigned* bar = b.bar;
        __builtin_amdgcn_s_waitcnt(0);
        unsigned nloc = b.st[0], nx = b.st[1];
        if (nloc == 0u) { xcd_barrier_complete(bar, b.x, nloc, nx); b.st[0] = nloc; b.st[1] = nx; }
        const unsigned old = xb_add(&bar[XB_XSUB(b.x)], 1u);
        const unsigned gen = old / nloc;
        if (old + 1u == (gen + 1u) * nloc) {
            __builtin_amdgcn_fence(__ATOMIC_RELEASE, "agent");
            asm volatile("s_waitcnt vmcnt(0)" ::: "memory");
            const unsigned og = xb_add(&bar[XB_TOP], 1u);
            const unsigned tg = og / nx;
            if (og + 1u == (tg + 1u) * nx) xb_add(&bar[XB_TOPGEN], 1u);
            else XB_SPIN(xb_ld(&bar[XB_TOPGEN]) == tg, bar);
            __builtin_amdgcn_fence(__ATOMIC_ACQUIRE, "agent");
            xb_add(&bar[XB_XGEN(b.x)], 1u);
            asm volatile("s_waitcnt vmcnt(0)" ::: "memory");
        } else {
            XB_SPIN(xb_ld(&bar[XB_XGEN(b.x)]) == gen, bar);
            __builtin_amdgcn_fence(__ATOMIC_ACQUIRE, "agent");
            asm volatile("s_waitcnt vmcnt(0)" ::: "memory");
        }
    }
    __syncthreads();
}

struct Frame {
    LAS unsigned char* lds;
    volatile LAS unsigned* MISC;
    gu32* ctl;
    int wave, G;
};
__device__ __forceinline__ float wave_sum(float v) {
#pragma unroll
    for (int o = 1; o < 64; o <<= 1) v += __shfl_xor(v, o);
    return v;
}

__device__ __forceinline__ void p0_adaln(Frame& F, const float* c, const float* cctx, const float* mod_w, float* MODP) {
    const int lane = lane_now(), tid = F.wave * 64 + lane; (void)tid; (void)lane;
    LAS float* S = (LAS float*)F.lds;
    LAS float* RED = S + 9 * 256;
    for (int it = blockIdx.x; it < 2 * 8 * 72; it += F.G) {
        const int l = it / 576, rem = it % 576, kb = rem / 72, cg = rem % 72;
        __syncthreads();
        for (int i = tid; i < 9 * 256; i += NWAVES * 64) { const int r = i >> 8, k = i & 255; const float cv = (r < 8) ? c[r * DM + kb * 256 + k] : cctx[kb * 256 + k]; S[i] = cv / (1.0f + __expf(-cv)); }
        __syncthreads();
        f32x4 acc[9];
#pragma unroll
        for (int r = 0; r < 9; ++r) acc[r] = (f32x4){0.f, 0.f, 0.f, 0.f};
        const float* W = mod_w + ((size_t)l * DM + kb * 256 + F.wave * 32) * NMOD + cg * 256 + lane * 4;
        f32x4 w[8], wn[8];
#pragma unroll
        for (int e = 0; e < 8; ++e) w[e] = __builtin_nontemporal_load((const f32x4*)(W + (size_t)e * NMOD));
#pragma unroll
        for (int k = 0; k < 32; k += 8) {
            if (k + 8 < 32) {
#pragma unroll
                for (int e = 0; e < 8; ++e) wn[e] = __builtin_nontemporal_load((const f32x4*)(W + (size_t)(k + 8 + e) * NMOD)); }
#pragma unroll
            for (int r = 0; r < 9; ++r) { const f32x4 s0 = *(const LAS f32x4*)(S + r * 256 + F.wave * 32 + k), s1 = *(const LAS f32x4*)(S + r * 256 + F.wave * 32 + k + 4);
                acc[r] += w[0] * s0.x + w[1] * s0.y + w[2] * s0.z + w[3] * s0.w + w[4] * s1.x + w[5] * s1.y + w[6] * s1.z + w[7] * s1.w; }
            if (k + 8 < 32) {
#pragma unroll
                for (int e = 0; e < 8; ++e) w[e] = wn[e]; }
        }
#pragma unroll
        for (int r = 0; r < 9; ++r) *(LAS f32x4*)(RED + (F.wave * 9 + r) * 256 + lane * 4) = acc[r];
        __syncthreads();
        for (int i = tid; i < 9 * 256; i += NWAVES * 64) { const int r = i >> 8, cc = i & 255; float s = 0.f;
#pragma unroll
            for (int w = 0; w < 8; ++w) s += RED[(w * 9 + r) * 256 + cc];
            MODP[((size_t)(l * 8 + kb) * 9 + r) * NMOD + cg * 256 + cc] = s; }
    }
    __syncthreads();
}
__device__ __forceinline__ void p0_adaln_reduce(Frame& F, const float* MODP, const float* mod_b, float* MOD) {
    const int lane = lane_now(), tid = F.wave * 64 + lane; (void)tid; (void)lane;
    for (int i = blockIdx.x * (NWAVES * 64) + tid; i < 2 * 9 * NMOD; i += F.G * NWAVES * 64) {
        const int l = i / (9 * NMOD), rn = i % (9 * NMOD), n = rn % NMOD;
        float s = mod_b[l * NMOD + n];
#pragma unroll
        for (int kb = 0; kb < 8; ++kb) s += MODP[(size_t)(l * 8 + kb) * 9 * NMOD + rn];
        MOD[i] = s;
    }
}

__device__ __forceinline__ void p0_transpose_load(f32x4 (&v)[8], const float* W, int N, int k0, int n0, int lane) {
    const int kr = lane >> 3, n4 = lane & 7;
#pragma unroll
    for (int i = 0; i < 8; ++i) v[i] = __builtin_nontemporal_load((const f32x4*)(W + (size_t)(k0 + kr + 8 * i) * N + n0 + 4 * n4));
}
__device__ __forceinline__ void p0_transpose_store(const f32x4 (&v)[8], bf16* WT, int ldt, int dst_row0, LAS float* scr, int k0, int lane) {
    const int kr = lane >> 3, n4 = lane & 7;
#pragma unroll
    for (int i = 0; i < 8; ++i) { LAS float* d = scr + (kr + 8 * i) * 33 + 4 * n4; d[0] = v[i].x; d[1] = v[i].y; d[2] = v[i].z; d[3] = v[i].w; }
    LDS_WAIT(); asm volatile("" ::: "memory");
    const int c = lane & 7;
#pragma unroll
    for (int j = 0; j < 4; ++j) { const int n = (lane >> 3) + 8 * j; const LAS float* s = scr + (8 * c) * 33 + n;
        v4u o; o.x = pk2(s[0 * 33], s[1 * 33]); o.y = pk2(s[2 * 33], s[3 * 33]); o.z = pk2(s[4 * 33], s[5 * 33]); o.w = pk2(s[6 * 33], s[7 * 33]);
        *(GAS v4u*)(WT + (size_t)(dst_row0 + n) * ldt + k0 + 8 * c) = o; }
    LDS_WAIT(); asm volatile("" ::: "memory");
}
__device__ __forceinline__ void p0_quant_win(Frame& F, const float* ffn_in, unsigned char* WinQ, float* SW) {
    const int lane = lane_now(), tid = F.wave * 64 + lane; (void)lane;
    LAS unsigned char* Q = F.lds;
    LAS float* red = (LAS float*)(F.lds + 32 * 2064);
    LAS float* inv = red + 64 * 32;
    const int n4 = tid & 7, kq = tid >> 3;
    __syncthreads();
    for (int it = F.G - 1 - (int)blockIdx.x; it < 4 * 352; it += F.G) {
        const int mi = it / 352, n0 = 32 * (it % 352);
        const int s = n0 / DFF, f = n0 % DFF, drow = 256 * (f / 128) + 128 * s + (f % 128);
        const float* W = ffn_in + (size_t)mi * DM * 2 * DFF + n0 + 4 * n4;
        f32x4 v[8][4]; f32x4 mx = (f32x4){0.f, 0.f, 0.f, 0.f};
#pragma unroll
        for (int i = 0; i < 8; ++i)
#pragma unroll
            for (int e = 0; e < 4; ++e) v[i][e] = __builtin_nontemporal_load((const f32x4*)(W + (size_t)(256 * i + 4 * kq + e) * (2 * DFF)));
#pragma unroll
        for (int i = 0; i < 8; ++i)
#pragma unroll
            for (int e = 0; e < 4; ++e) { mx.x = fmaxf(mx.x, fabsf(v[i][e].x)); mx.y = fmaxf(mx.y, fabsf(v[i][e].y)); mx.z = fmaxf(mx.z, fabsf(v[i][e].z)); mx.w = fmaxf(mx.w, fabsf(v[i][e].w)); }
        *(LAS f32x4*)(red + kq * 32 + 4 * n4) = mx;
        __syncthreads();
        if (tid < 32) { float m = 0.f;
#pragma unroll 8
            for (int r = 0; r < 64; ++r) m = fmaxf(m, red[r * 32 + tid]);
            SW[(size_t)mi * 2 * DFF + drow + tid] = m > 0.f ? m * (1.0f / 127.0f) : 1.0f; inv[tid] = m > 0.f ? 127.0f / m : 0.f; }
        __syncthreads();
        const f32x4 iv = *(const LAS f32x4*)(inv + 4 * n4);
#pragma unroll
        for (int i = 0; i < 8; ++i)
#pragma unroll
            for (int c = 0; c < 4; ++c) { unsigned p = 0u;
#pragma unroll
                for (int e = 0; e < 4; ++e) p |= ((unsigned)(int)__builtin_rintf(v[i][e][c] * iv[c]) & 0xffu) << (8 * e);
                *(LAS unsigned*)(Q + (4 * n4 + c) * 2064 + 256 * i + 4 * kq) = p; }
        __syncthreads();
        { const int row = tid >> 4, seg = tid & 15;
#pragma unroll
          for (int j = 0; j < 8; ++j) *(GAS v4u*)(WinQ + ((size_t)mi * 2 * DFF + drow + row) * DM + 16 * (seg + 16 * j)) = *(const LAS v4u*)(Q + row * 2064 + 16 * (seg + 16 * j)); }
        __syncthreads();
    }
}
struct WeightPtrs { const float *ffn_out, *rec_in, *rec_out, *fou_out, *gate_w; bf16 *WoutT, *WrinT, *WroutT, *WfouT, *GW; };
__device__ __forceinline__ void p0_weights(Frame& F, const WeightPtrs& P) {
    const int lane = lane_now(), tid = F.wave * 64 + lane; (void)tid; (void)lane;
    LAS float* scr = (LAS float*)(F.lds + RING_OFF + F.wave * 16384);
    const int gw = blockIdx.x * NWAVES + F.wave, NGW = F.G * NWAVES;
    constexpr int I_OUT = (DFF / 64) * (DM / 32), I_RIN = (DM / 64) * (2 * DM / 32), I_SQ = (DM / 64) * (DM / 32), I_G = 2 * 4;
    constexpr int NITEMS = 4 * I_OUT + I_RIN + 2 * I_SQ + 64 * I_G;
#define P0_ITEM(it_, W_, N_, WT_, ldt_, drow_, k0_, n0_) do { int r_ = (it_); \
        if (r_ < 4 * I_OUT) { const int mi = r_ / I_OUT, q = r_ % I_OUT, nblk = DM / 32; W_ = P.ffn_out + (size_t)mi * DFF * DM; N_ = DM; WT_ = P.WoutT + (size_t)mi * WOUT_ELEMS; ldt_ = DFF; k0_ = 64 * (q / nblk); n0_ = 32 * (q % nblk); } \
        else if ((r_ -= 4 * I_OUT) < I_RIN) { const int nblk = 2 * DM / 32; W_ = P.rec_in; N_ = 2 * DM; WT_ = P.WrinT; ldt_ = DM; k0_ = 64 * (r_ / nblk); n0_ = 32 * (r_ % nblk); } \
        else if ((r_ -= I_RIN) < 2 * I_SQ) { const int mi = r_ / I_SQ, q = r_ % I_SQ, nblk = DM / 32; W_ = mi ? P.fou_out : P.rec_out; N_ = DM; WT_ = mi ? P.WfouT : P.WroutT; ldt_ = DM; k0_ = 64 * (q / nblk); n0_ = 32 * (q % nblk); } \
        else { r_ -= 2 * I_SQ; const int mi = r_ / I_G, q = r_ % I_G; W_ = P.gate_w + (size_t)mi * 128 * 128; N_ = 128; WT_ = P.GW + (size_t)mi * 128 * 128; ldt_ = 128; k0_ = 64 * (q / 4); n0_ = 32 * (q % 4); } \
        drow_ = n0_; } while (0)
    const float* Wc; bf16* WTc; int Nc, ldc, drc, k0c, n0c; f32x4 vc[8];
    int it = gw;
    if (it < NITEMS) { P0_ITEM(it, Wc, Nc, WTc, ldc, drc, k0c, n0c); p0_transpose_load(vc, Wc, Nc, k0c, n0c, lane); }
    while (it < NITEMS) {
        const int nx = it + NGW; const float* Wn = Wc; bf16* WTn = WTc; int Nn = Nc, ldn = ldc, drn = drc, k0n = k0c, n0n = n0c; f32x4 vn[8];
        if (nx < NITEMS) { P0_ITEM(nx, Wn, Nn, WTn, ldn, drn, k0n, n0n); p0_transpose_load(vn, Wn, Nn, k0n, n0n, lane); }
        p0_transpose_store(vc, WTc, ldc, drc, scr, k0c, lane);
        if (nx < NITEMS) {
#pragma unroll
            for (int i = 0; i < 8; ++i) vc[i] = vn[i];
            Wc = Wn; WTc = WTn; Nc = Nn; ldc = ldn; drc = drn; k0c = k0n; n0c = n0n; }
        it = nx;
    }
#undef P0_ITEM
}
__device__ __forceinline__ void p0_twiddles(Frame& F, bf16* T2, bf16* TW) {
    const int lane = lane_now(), tid = F.wave * 64 + lane; (void)tid; (void)lane;
    const int gt = blockIdx.x * (NWAVES * 64) + tid, NGT = F.G * NWAVES * 64;
    for (int i = gt; i < 1024 * 2048 / 8; i += NGT) {
        const int k1 = i >> 8, col = (i & 255) * 8, cs = col >> 10, n0 = col & 1023;
        float v[8];
#pragma unroll
        for (int e = 0; e < 8; ++e) { const int m = (k1 * (n0 + e)) & 2047; const float ang = (float)m * (1.0f / 1024.0f); v[e] = cs ? -sinpif(ang) : cospif(ang); }
        v4u o; o.x = pk2(v[0], v[1]); o.y = pk2(v[2], v[3]); o.z = pk2(v[4], v[5]); o.w = pk2(v[6], v[7]);
        *(GAS v4u*)(T2 + (size_t)i * 8) = o;
    }
    for (int i = gt; i < 512 * 256 / 8; i += NGT) {
        const int row = i >> 5, c0 = (i & 31) * 8, cs = row >> 8, k2 = row & 255;
        float v[8];
#pragma unroll
        for (int e = 0; e < 8; ++e) { const int m = (k2 * (c0 + e)) & 255; const float ang = (float)m * (1.0f / 128.0f); v[e] = cs ? sinpif(ang) : cospif(ang); }
        v4u o; o.x = pk2(v[0], v[1]); o.y = pk2(v[2], v[3]); o.z = pk2(v[4], v[5]); o.w = pk2(v[6], v[7]);
        *(GAS v4u*)(TW + (size_t)i * 8) = o;
    }
}

template <bool RES, bool HOUT, bool CTX, bool XIN16, bool XOUT16, bool H8, bool ALT = false, bool MODRAW = false>
__device__ __forceinline__ void thin_phase(Frame& F, const void* xl, const void* xc, const bf16* Yb, const bf16* YC, void* ol, bf16* H, float* SA, float* PA,
                                           const float* gpost, const float* modr, int gate_ch, float coef, const float* gpre, const float* modn, int sh_ch, int sc_ch,
                                           const float* MODPr = nullptr, const float* modb = nullptr) {
    auto modv = [&](int row, int ch, int i) -> float {
        if (!MODRAW) return modn[(row * 9 + ch) * DM + i];
        const int n = ch * DM + i; float s = modb[n];
#pragma unroll
        for (int kb = 0; kb < 8; ++kb) s += MODPr[((size_t)kb * 9 + row) * NMOD + n];
        return s; };
    const int lane = lane_now(), tid = F.wave * 64 + lane; (void)tid; (void)lane;
    LAS float* VA = (LAS float*)F.lds;
    LAS float* VB = VA + 2 * DM;
    LAS float* VC = VB + 2 * DM;
    for (int vb = blockIdx.x; vb < 256; vb += F.G) {
        const int b = vb >> 5;
        __syncthreads();
        for (int i = tid; i < DM; i += NWAVES * 64) {
            if (RES) { const float gp = coef * gpost[i]; VA[i] = gp * modr[(b * 9 + gate_ch) * DM + i]; if (CTX) VA[DM + i] = gp * modr[(8 * 9 + gate_ch) * DM + i]; }
            if (HOUT) { const float gq = gpre[i]; VB[i] = gq * (1.0f + modv(b, sc_ch, i)); VC[i] = modv(b, sh_ch, i);
                if (CTX) { VB[DM + i] = gq * (1.0f + modv(8, sc_ch, i)); VC[DM + i] = modv(8, sh_ch, i); } }
        }
        __syncthreads();
        f32x4 alt[8];
#pragma unroll
        for (int j = 0; j < 8; ++j) alt[j] = (f32x4){0.f, 0.f, 0.f, 0.f};
        constexpr bool PF = XIN16 && RES && !CTX;
        v2u xnx[8], ynx[8];
        if (PF) { const v2u* xr = (const v2u*)((const unsigned short*)xl + (size_t)(vb * 64 + F.wave) * DM) + lane; const v2u* yr = (const v2u*)(Yb + (size_t)(vb * 64 + F.wave) * DM) + lane;
#pragma unroll
            for (int j = 0; j < 8; ++j) { xnx[j] = __builtin_nontemporal_load(xr + 64 * j); ynx[j] = __builtin_nontemporal_load(yr + 64 * j); } }
        for (int rr = F.wave; rr < (CTX ? 72 : 64); rr += NWAVES) {
            const bool isctx = rr >= 64; const int lrow = isctx ? vb * 8 + (rr - 64) : vb * 64 + rr, row = isctx ? MLAT + lrow : lrow, vo = isctx ? DM / 4 : 0;
            f32x4 xv[8]; v2u xcu[8], ycu[8];
            if (PF) {
#pragma unroll
                for (int j = 0; j < 8; ++j) { xcu[j] = xnx[j]; ycu[j] = ynx[j]; }
                if (rr + NWAVES < 64) { const v2u* xr = (const v2u*)((const unsigned short*)xl + (size_t)(lrow + NWAVES) * DM) + lane; const v2u* yr = (const v2u*)(Yb + (size_t)(lrow + NWAVES) * DM) + lane;
#pragma unroll
                    for (int j = 0; j < 8; ++j) { xnx[j] = __builtin_nontemporal_load(xr + 64 * j); ynx[j] = __builtin_nontemporal_load(yr + 64 * j); } }
            }
            if (XIN16) { const v2u* xr = (const v2u*)((const unsigned short*)xl + (size_t)lrow * DM) + lane;
#pragma unroll
                for (int j = 0; j < 8; ++j) { const v2u w = PF ? xcu[j] : __builtin_nontemporal_load(xr + 64 * j); xv[j] = (f32x4){h_lo(w.x), h_hi(w.x), h_lo(w.y), h_hi(w.y)}; }
            } else { const f32x4* xr = (const f32x4*)((const float*)(isctx ? xc : xl) + (size_t)lrow * DM) + lane;
#pragma unroll
                for (int j = 0; j < 8; ++j) xv[j] = __builtin_nontemporal_load(xr + 64 * j); }
            if (RES) {
                f32x4 yv[8]; float ss = 0.f;
                if (!isctx) { const v2u* yr = (const v2u*)(Yb + (size_t)row * DM) + lane;
#pragma unroll
                    for (int j = 0; j < 8; ++j) { const v2u w = PF ? ycu[j] : __builtin_nontemporal_load(yr + 64 * j); yv[j] = (f32x4){bf_lo(w.x), bf_hi(w.x), bf_lo(w.y), bf_hi(w.y)}; }
                } else { const v2u* yr = (const v2u*)(YC + (size_t)lrow * DM) + lane;
#pragma unroll
                    for (int j = 0; j < 8; ++j) { const v2u w0 = yr[64 * j], w1 = yr[CSL / 4 + 64 * j], w2 = yr[2 * (CSL / 4) + 64 * j], w3 = yr[3 * (CSL / 4) + 64 * j];
                        yv[j] = (f32x4){(bf_lo(w0.x) + bf_lo(w1.x)) + (bf_lo(w2.x) + bf_lo(w3.x)), (bf_hi(w0.x) + bf_hi(w1.x)) + (bf_hi(w2.x) + bf_hi(w3.x)),
                                        (bf_lo(w0.y) + bf_lo(w1.y)) + (bf_lo(w2.y) + bf_lo(w3.y)), (bf_hi(w0.y) + bf_hi(w1.y)) + (bf_hi(w2.y) + bf_hi(w3.y))}; } }
#pragma unroll
                for (int j = 0; j < 8; ++j) ss += (yv[j].x * yv[j].x + yv[j].y * yv[j].y) + (yv[j].z * yv[j].z + yv[j].w * yv[j].w);
                const float rstd = rsqrtf(wave_sum(ss) * (1.0f / DM) + EPS);
#pragma unroll
                for (int j = 0; j < 8; ++j) { const f32x4 va = ((const LAS f32x4*)VA)[vo + 64 * j + lane]; xv[j] = xv[j] + va * yv[j] * rstd; }
                if (!isctx) {
                    if (XOUT16) { GAS v2u* orow = (GAS v2u*)((unsigned short*)ol + (size_t)lrow * DM) + lane;
#pragma unroll
                        for (int j = 0; j < 8; ++j) { v2u o; o.x = pkh2(xv[j].x, xv[j].y); o.y = pkh2(xv[j].z, xv[j].w); __builtin_nontemporal_store(o, orow + 64 * j);
                            if (HOUT) xv[j] = (f32x4){h_lo(o.x), h_hi(o.x), h_lo(o.y), h_hi(o.y)}; }
                    } else { f32x4* orow = (f32x4*)((float*)ol + (size_t)lrow * DM) + lane;
#pragma unroll
                        for (int j = 0; j < 8; ++j) orow[64 * j] = xv[j]; }
                }
            }
            if (HOUT) {
                float ss = 0.f;
#pragma unroll
                for (int j = 0; j < 8; ++j) ss += (xv[j].x * xv[j].x + xv[j].y * xv[j].y) + (xv[j].z * xv[j].z + xv[j].w * xv[j].w);
                const float rstd = rsqrtf(wave_sum(ss) * (1.0f / DM) + EPS);
                if (H8) {
                    float am = 0.f;
#pragma unroll
                    for (int j = 0; j < 8; ++j) { const f32x4 vb4 = ((const LAS f32x4*)VB)[vo + 64 * j + lane], vc4 = ((const LAS f32x4*)VC)[vo + 64 * j + lane];
                        xv[j] = xv[j] * rstd * vb4 + vc4; am = fmaxf(fmaxf(am, fmaxf(fabsf(xv[j].x), fabsf(xv[j].y))), fmaxf(fabsf(xv[j].z), fabsf(xv[j].w))); }
#pragma unroll
                    for (int o = 1; o < 64; o <<= 1) am = fmaxf(am, __shfl_xor(am, o));
                    const float inv = am > 0.f ? 127.0f / am : 0.f;
                    if (lane == 0) SA[row] = am > 0.f ? am * (1.0f / 127.0f) : 1.0f;
                    GAS unsigned* hrow = (GAS unsigned*)((unsigned char*)H + (size_t)row * DM) + lane;
#pragma unroll
                    for (int j = 0; j < 8; ++j) hrow[64 * j] = ((unsigned)(int)__builtin_rintf(xv[j].x * inv) & 0xffu) | (((unsigned)(int)__builtin_rintf(xv[j].y * inv) & 0xffu) << 8)
                                                             | (((unsigned)(int)__builtin_rintf(xv[j].z * inv) & 0xffu) << 16) | ((unsigned)(int)__builtin_rintf(xv[j].w * inv) << 24);
                } else {
                GAS v2u* hrow = (GAS v2u*)(H + (size_t)row * DM) + lane;
#pragma unroll
                for (int j = 0; j < 8; ++j) { const f32x4 vb4 = ((const LAS f32x4*)VB)[vo + 64 * j + lane], vc4 = ((const LAS f32x4*)VC)[vo + 64 * j + lane];
                    const f32x4 h = xv[j] * rstd * vb4 + vc4; v2u o; o.x = pk2(h.x, h.y); o.y = pk2(h.z, h.w); hrow[64 * j] = o;
                    if (ALT) alt[j] += (lrow & 1) ? -h : h; }
                }
            }
        }
        if (ALT) {
            LAS float* AL = VC + 2 * DM;
#pragma unroll
            for (int j = 0; j < 8; ++j) *(LAS f32x4*)(AL + F.wave * DM + 4 * (64 * j + lane)) = alt[j];
            __syncthreads();
            for (int i = tid; i < DM; i += NWAVES * 64) { float s = 0.f;
#pragma unroll
                for (int w = 0; w < 8; ++w) s += AL[w * DM + i];
                PA[(size_t)vb * DM + i] = s; }
        }
    }
    __syncthreads();
}

__device__ __forceinline__ void fold_row(const v2u (&xr)[8], const v2u (&yr)[8], unsigned short* XSp, int lrow, int lane, const LAS float* VA, const LAS float* VB, const LAS float* VC, f32x4 (&h)[8]) {
    f32x4 yv[8]; float ss = 0.f;
#pragma unroll
    for (int j = 0; j < 8; ++j) { h[j] = (f32x4){h_lo(xr[j].x), h_hi(xr[j].x), h_lo(xr[j].y), h_hi(xr[j].y)}; yv[j] = (f32x4){bf_lo(yr[j].x), bf_hi(yr[j].x), bf_lo(yr[j].y), bf_hi(yr[j].y)}; }
#pragma unroll
    for (int j = 0; j < 8; ++j) ss += (yv[j].x * yv[j].x + yv[j].y * yv[j].y) + (yv[j].z * yv[j].z + yv[j].w * yv[j].w);
    const float rstd = rsqrtf(wave_sum(ss) * (1.0f / DM) + EPS);
    GAS v2u* orow = (GAS v2u*)(XSp + (size_t)lrow * DM) + lane;
    float s2 = 0.f;
#pragma unroll
    for (int j = 0; j < 8; ++j) { const f32x4 va = ((const LAS f32x4*)VA)[64 * j + lane]; const f32x4 xn = h[j] + va * yv[j] * rstd;
        v2u o; o.x = pkh2(xn.x, xn.y); o.y = pkh2(xn.z, xn.w); __builtin_nontemporal_store(o, orow + 64 * j);
        h[j] = (f32x4){h_lo(o.x), h_hi(o.x), h_lo(o.y), h_hi(o.y)};
        s2 += (h[j].x * h[j].x + h[j].y * h[j].y) + (h[j].z * h[j].z + h[j].w * h[j].w); }
    const float rstd2 = rsqrtf(wave_sum(s2) * (1.0f / DM) + EPS);
#pragma unroll
    for (int j = 0; j < 8; ++j) { const f32x4 vb4 = ((const LAS f32x4*)VB)[64 * j + lane], vc4 = ((const LAS f32x4*)VC)[64 * j + lane]; h[j] = h[j] * rstd2 * vb4 + vc4; }
}
__device__ __forceinline__ void thin_fold_phase(Frame& F, unsigned short* XSp, const bf16* Yb, bf16* H, float* PA, float* HN2,
                                                const float* gpost, const float* modr, int gate_ch, float coef, const float* gpre, const float* modn, int sh_ch, int sc_ch) {
    const int lane = lane_now(), tid = F.wave * 64 + lane; (void)tid; (void)lane;
    LAS float* VA = (LAS float*)F.lds; LAS float* VB = VA + 2 * DM; LAS float* VC = VB + 2 * DM;
    for (int vb = blockIdx.x; vb < 256; vb += F.G) {
        const int b = vb >> 5, jb = vb & 31;
        __syncthreads();
        for (int i = tid; i < DM; i += NWAVES * 64) {
            VA[i] = coef * gpost[i] * modr[(b * 9 + gate_ch) * DM + i];
            VB[i] = gpre[i] * (1.0f + modn[(b * 9 + sc_ch) * DM + i]); VC[i] = modn[(b * 9 + sh_ch) * DM + i]; }
        __syncthreads();
        f32x4 alt[8];
#pragma unroll
        for (int j = 0; j < 8; ++j) alt[j] = (f32x4){0.f, 0.f, 0.f, 0.f};
        v2u xc[8], yc[8], xn[8], yn[8];
        { const int n0 = 32 * jb + F.wave; const v2u* p0 = (const v2u*)(XSp + (size_t)(b * SEQ + n0) * DM) + lane; const v2u* p1 = (const v2u*)(Yb + (size_t)(b * SEQ + n0) * DM) + lane;
#pragma unroll
          for (int j = 0; j < 8; ++j) { xc[j] = __builtin_nontemporal_load(p0 + 64 * j); yc[j] = __builtin_nontemporal_load(p1 + 64 * j); } }
        for (int rr = F.wave; rr < 32; rr += NWAVES) {
            const int n = 32 * jb + rr, m = n ? SEQ - n : SEQ / 2, rowa = b * SEQ + n, rowb = b * SEQ + m;
            { const v2u* p2 = (const v2u*)(XSp + (size_t)rowb * DM) + lane; const v2u* p3 = (const v2u*)(Yb + (size_t)rowb * DM) + lane;
#pragma unroll
              for (int j = 0; j < 8; ++j) { xn[j] = __builtin_nontemporal_load(p2 + 64 * j); yn[j] = __builtin_nontemporal_load(p3 + 64 * j); } }
            f32x4 hA[8], hB[8];
            fold_row(xc, yc, XSp, rowa, lane, VA, VB, VC, hA);
            asm volatile("" ::: "memory");
            if (rr + NWAVES < 32) { const int rown = rowa + NWAVES; const v2u* p0 = (const v2u*)(XSp + (size_t)rown * DM) + lane; const v2u* p1 = (const v2u*)(Yb + (size_t)rown * DM) + lane;
#pragma unroll
                for (int j = 0; j < 8; ++j) { xc[j] = __builtin_nontemporal_load(p0 + 64 * j); yc[j] = __builtin_nontemporal_load(p1 + 64 * j); } }
            fold_row(xn, yn, XSp, rowb, lane, VA, VB, VC, hB);
            GAS v2u* srow = (GAS v2u*)(H + (size_t)(b * SEQ + n) * DM) + lane; GAS v2u* drow = (GAS v2u*)(H + (size_t)(b * SEQ + SEQ / 2 + n) * DM) + lane;
            if (n) {
#pragma unroll
                for (int j = 0; j < 8; ++j) { const f32x4 hs = hA[j] + hB[j], hd = hA[j] - hB[j]; v2u o; o.x = pk2(hs.x, hs.y); o.y = pk2(hs.z, hs.w); srow[64 * j] = o;
                    v2u q; q.x = pk2(hd.x, hd.y); q.y = pk2(hd.z, hd.w); drow[64 * j] = q; alt[j] += (n & 1) ? -hs : hs; }
            } else {
                f32x4* nrow = (f32x4*)(HN2 + (size_t)b * DM) + lane;
#pragma unroll
                for (int j = 0; j < 8; ++j) { v2u o; o.x = pk2(hA[j].x, hA[j].y); o.y = pk2(hA[j].z, hA[j].w); srow[64 * j] = o; drow[64 * j] = (v2u){0u, 0u}; nrow[64 * j] = hB[j]; alt[j] += hA[j] + hB[j]; }
            }
        }
        {
            LAS float* AL = VC + 2 * DM;
#pragma unroll
            for (int j = 0; j < 8; ++j) *(LAS f32x4*)(AL + F.wave * DM + 4 * (64 * j + lane)) = alt[j];
            __syncthreads();
            for (int i = tid; i < DM; i += NWAVES * 64) { float s = 0.f;
#pragma unroll
                for (int w = 0; w < 8; ++w) s += AL[w * DM + i];
                PA[(size_t)vb * DM + i] = s; }
        }
    }
    __syncthreads();
}

constexpr int VROW = 272;
constexpr int SC_IMG = 64 * VROW, SC_CTX = 4 * SC_IMG;
static_assert(SC_CTX + 4 * SC_IMG <= 143360 && 259 * 256 <= 4 * SC_IMG, "scan LDS");
__device__ __forceinline__ int rho_of(int t) { return 16 * ((t >> 2) & 3) + 4 * (t >> 4) + (t & 3); }
__device__ __forceinline__ void scan_phase(Frame& F, const bf16* VCV, const bf16* VC, bf16* G, bf16* YP, const bf16* GW, const float* conv_w, const float* conv_b, const float* gate_b, const float* lam) {
    const int lane = lane_now(), tid = F.wave * 64 + lane; (void)tid; (void)lane;
    const int hb = F.wave >> 2, wv = F.wave & 3, th = tid & 255, jj = lane & 15, g = lane >> 4, d = hb;
    LAS unsigned char* CTXI = F.lds;
    LAS unsigned char* IMG = F.lds + SC_CTX + hb * 2 * SC_IMG;
    LAS unsigned char* RAW = F.lds + SC_CTX;
    for (int u = blockIdx.x; u < 256; u += F.G) {
        const int b = u >> 5, q = u & 31, hd = q >> 1, half = q & 1, ch0 = hd * 128, jl = half * 64 + wv * 16 + jj, cj = ch0 + jl;
        const int col16 = tid & 15;
        __syncthreads();
        if (tid < 48) *(LAS v4u*)(RAW + ((tid >> 4) == 2 ? 258 : (tid >> 4)) * 256 + col16 * 16) = (v4u){0u, 0u, 0u, 0u};
#pragma unroll 2
        for (int it = 0; it < 8; ++it) { const int tok = (tid >> 4) + 32 * it; const bf16* p = VC + (size_t)(b * CTXL + tok) * DM + ch0 + 8 * col16;
            const v4u p0 = *(const v4u*)p, p1 = *(const v4u*)(p + CSL), p2 = *(const v4u*)(p + 2 * CSL), p3 = *(const v4u*)(p + 3 * CSL);
            v4u w;
            w.x = pk2((bf_lo(p0.x) + bf_lo(p1.x)) + (bf_lo(p2.x) + bf_lo(p3.x)), (bf_hi(p0.x) + bf_hi(p1.x)) + (bf_hi(p2.x) + bf_hi(p3.x)));
            w.y = pk2((bf_lo(p0.y) + bf_lo(p1.y)) + (bf_lo(p2.y) + bf_lo(p3.y)), (bf_hi(p0.y) + bf_hi(p1.y)) + (bf_hi(p2.y) + bf_hi(p3.y)));
            w.z = pk2((bf_lo(p0.z) + bf_lo(p1.z)) + (bf_lo(p2.z) + bf_lo(p3.z)), (bf_hi(p0.z) + bf_hi(p1.z)) + (bf_hi(p2.z) + bf_hi(p3.z)));
            w.w = pk2((bf_lo(p0.w) + bf_lo(p1.w)) + (bf_lo(p2.w) + bf_lo(p3.w)), (bf_hi(p0.w) + bf_hi(p1.w)) + (bf_hi(p2.w) + bf_hi(p3.w)));
            *(LAS v4u*)(RAW + (tok + 2) * 256 + col16 * 16) = w; }
        __syncthreads();
        { float cw[4][8], cb[8];
#pragma unroll
          for (int e = 0; e < 8; ++e) { cb[e] = conv_b[ch0 + 8 * col16 + e];
#pragma unroll
              for (int k = 0; k < 4; ++k) cw[k][e] = conv_w[k * DM + ch0 + 8 * col16 + e]; }
#pragma unroll 2
          for (int it = 0; it < 8; ++it) { const int tok = (tid >> 4) + 32 * it; float o[8];
#pragma unroll
              for (int e = 0; e < 8; ++e) o[e] = cb[e];
#pragma unroll
              for (int kk = 0; kk < 4; ++kk) { const v4u r = *(const LAS v4u*)(RAW + (tok + kk) * 256 + col16 * 16);
                  o[0] += cw[kk][0] * bf_lo(r.x); o[1] += cw[kk][1] * bf_hi(r.x); o[2] += cw[kk][2] * bf_lo(r.y); o[3] += cw[kk][3] * bf_hi(r.y);
                  o[4] += cw[kk][4] * bf_lo(r.z); o[5] += cw[kk][5] * bf_hi(r.z); o[6] += cw[kk][6] * bf_lo(r.w); o[7] += cw[kk][7] * bf_hi(r.w); }
              v4u w; w.x = pk2(o[0], o[1]); w.y = pk2(o[2], o[3]); w.z = pk2(o[4], o[5]); w.w = pk2(o[6], o[7]);
              *(LAS v4u*)(CTXI + (tok >> 6) * SC_IMG + rho_of(tok & 63) * VROW + col16 * 16) = w; } }
        const float ba = gate_b[(d * 2 + 0) * DM + cj], bx = gate_b[(d * 2 + 1) * DM + cj];
        const float lm = lam[d * DM + cj];
        const float sp = fmaxf(-lm, 0.f) + log1pf(__expf(-fabsf(lm)));
        const float cneg2 = -8.0f * sp * 1.4426950408889634f;
        bf16x8 Bf[2][4];
#pragma unroll
        for (int gt = 0; gt < 2; ++gt)
#pragma unroll
            for (int s = 0; s < 4; ++s) Bf[gt][s] = *(const bf16x8*)(GW + ((size_t)((d * 2 + gt) * 16 + hd) * 128 + jl) * 128 + 32 * s + 8 * g);
#pragma unroll
        for (int gt = 0; gt < 2; ++gt)
#pragma unroll
            for (int s = 0; s < 4; ++s) asm volatile("" : "+v"(Bf[gt][s]));
        const int trow = th >> 4;
        const unsigned eoff = (unsigned)(16 * g) * DM + (unsigned)cj;
        float carry = 0.f;
        v4u vpre[4];
        __syncthreads();
#define SCAN_CHUNK(j, isctx, cidx, rowbase) const bool isctx = (j) < 4; const int cidx = isctx ? (d ? 3 - (j) : (j)) : (d ? 35 - (j) : (j) - 4); const int rowbase = b * SEQ + 64 * cidx;
        for (int k = 0; k < 36; ++k) {
            SCAN_CHUNK(k, isctx, cidx, rowbase)
            const bool fin = !isctx && (d ? cidx <= 15 : cidx >= 16);
            bf16* const Gu = G + (size_t)rowbase * DM;
            if (k + 1 >= 4 && k + 1 < 36) {
#pragma unroll
                for (int it = 0; it < 4; ++it) *(LAS v4u*)(IMG + ((k + 1) & 1) * SC_IMG + rho_of(trow + 16 * it) * VROW + col16 * 16) = vpre[it]; }
            if (k + 2 >= 4 && k + 2 < 36) { SCAN_CHUNK(k + 2, pc_, pi_, pr_) (void)pc_; (void)pi_;
#pragma unroll
                for (int it = 0; it < 4; ++it) vpre[it] = *(const v4u*)(VCV + (size_t)(pr_ + trow + 16 * it) * DM + ch0 + 8 * col16); }
            float yp[16]; unsigned gg[16];
            if (fin) {
#pragma unroll
                for (int i = 0; i < 16; ++i) gg[i] = Gu[eoff + (unsigned)i * DM];
                { const v4u* ypt = (const v4u*)(YP + ((size_t)(b * DM + cj) * SEQ + 64 * cidx + 16 * g)); const v4u y0 = ypt[0], y1 = ypt[1];
                  yp[0] = bf_lo(y0.x); yp[1] = bf_hi(y0.x); yp[2] = bf_lo(y0.y); yp[3] = bf_hi(y0.y); yp[4] = bf_lo(y0.z); yp[5] = bf_hi(y0.z); yp[6] = bf_lo(y0.w); yp[7] = bf_hi(y0.w);
                  yp[8] = bf_lo(y1.x); yp[9] = bf_hi(y1.x); yp[10] = bf_lo(y1.y); yp[11] = bf_hi(y1.y); yp[12] = bf_lo(y1.z); yp[13] = bf_hi(y1.z); yp[14] = bf_lo(y1.w); yp[15] = bf_hi(y1.w); }
            }
            const LAS unsigned char* VCk = isctx ? (const LAS unsigned char*)(CTXI + cidx * SC_IMG) : (const LAS unsigned char*)(IMG + (k & 1) * SC_IMG);
            f32x4 Cr[4], Ci[4];
#pragma unroll
            for (int m = 0; m < 4; ++m) { Cr[m] = (f32x4){0.f, 0.f, 0.f, 0.f}; Ci[m] = (f32x4){0.f, 0.f, 0.f, 0.f}; }
#pragma unroll
            for (int s = 0; s < 4; ++s)
#pragma unroll
                for (int m = 0; m < 4; ++m) { const bf16x8 a = *(const LAS bf16x8*)(VCk + (16 * m + jj) * VROW + (32 * s + 8 * g) * 2);
                    Cr[m] = __builtin_amdgcn_mfma_f32_16x16x32_bf16(a, Bf[0][s], Cr[m], 0, 0, 0);
                    Ci[m] = __builtin_amdgcn_mfma_f32_16x16x32_bf16(a, Bf[1][s], Ci[m], 0, 0, 0); }
            float av[16], bv[16];
#pragma unroll
            for (int m = 0; m < 4; ++m)
#pragma unroll
                for (int r = 0; r < 4; ++r) { const int i = 4 * m + r;
                    const float vc = __uint_as_float((unsigned)(*(const LAS unsigned short*)(VCk + (16 * m + 4 * g + r) * VROW + jl * 2)) << 16);
                    const float rg = pg8::sigmoid_f(Cr[m][r] + ba), ig = pg8::sigmoid_f(Ci[m][r] + bx);
                    const float a = __builtin_amdgcn_exp2f(rg * cneg2);
                    av[i] = a; bv[i] = __builtin_amdgcn_sqrtf(fmaxf(1.0f - a * a, 0.f)) * ig * vc; }
            float P = 1.f, Hh = 0.f;
            if (d == 0) {
#pragma unroll
                for (int i = 0; i < 16; ++i) { Hh = av[i] * Hh + bv[i]; P *= av[i]; }
            } else {
#pragma unroll
                for (int i = 15; i >= 0; --i) { Hh = av[i] * Hh + bv[i]; P *= av[i]; }
            }
            float Pk[4], Hk[4];
#pragma unroll
            for (int kk = 0; kk < 4; ++kk) { Pk[kk] = __shfl(P, jj + 16 * kk); Hk[kk] = __shfl(Hh, jj + 16 * kk); }
            float s = carry, cin = 0.f;
            if (d == 0) {
#pragma unroll
                for (int kk = 0; kk < 4; ++kk) { if (kk == g) cin = s; s = Pk[kk] * s + Hk[kk]; }
            } else {
#pragma unroll
                for (int kk = 3; kk >= 0; --kk) { if (kk == g) cin = s; s = Pk[kk] * s + Hk[kk]; }
            }
            carry = s;
            if (!isctx) {
                float h = cin;
                if (d == 0) {
#pragma unroll
                    for (int i = 0; i < 16; ++i) { h = av[i] * h + bv[i]; av[i] = h; }
                } else {
#pragma unroll
                    for (int i = 15; i >= 0; --i) { h = av[i] * h + bv[i]; av[i] = h; }
                }
                if (fin) {
#pragma unroll
                    for (int i = 0; i < 16; i += 2) { const unsigned w = pg8::cvt_pk_bf16(__uint_as_float(gg[i] << 16) * (av[i] + yp[i]), __uint_as_float(gg[i + 1] << 16) * (av[i + 1] + yp[i + 1]));
                        Gu[eoff + (unsigned)i * DM] = (bf16)(w & 0xffffu); Gu[eoff + (unsigned)(i + 1) * DM] = (bf16)(w >> 16); }
                } else {
                    { v4u* ypt = (v4u*)(YP + ((size_t)(b * DM + cj) * SEQ + 64 * cidx + 16 * g)); v4u y0, y1;
                      y0.x = pk2(av[0], av[1]); y0.y = pk2(av[2], av[3]); y0.z = pk2(av[4], av[5]); y0.w = pk2(av[6], av[7]);
                      y1.x = pk2(av[8], av[9]); y1.y = pk2(av[10], av[11]); y1.z = pk2(av[12], av[13]); y1.w = pk2(av[14], av[15]); ypt[0] = y0; ypt[1] = y1; }
                }
            }
            if (k == 19) VM_WAIT();
            __syncthreads();
        }
#undef SCAN_CHUNK
    }
}

struct Args { const float* in[17]; float* out; unsigned char* ws; };
__global__ void __launch_bounds__(NWAVES * 64, 2) fwd_kernel(Args args) {
    extern __shared__ __attribute__((aligned(16))) unsigned char lds[];
    Frame F;
    F.lds = (LAS unsigned char*)lds;
    F.MISC = (volatile LAS unsigned*)(F.lds + MISC_OFF);
    F.wave = __builtin_amdgcn_readfirstlane((int)threadIdx.x >> 6);
    F.G = gridDim.x;
    const int lane = lane_now(), tid = F.wave * 64 + lane; (void)lane;
    unsigned char* ws = args.ws;
    F.ctl = (gu32*)(ws + WS_CTL);
    for (int u = tid; u < (LDS_BYTES - LDSCTL_OFF) / 4; u += NWAVES * 64) ((LAS unsigned*)(F.lds + LDSCTL_OFF))[u] = 0u;
    __syncthreads();
    XcdBarrier bar = xcd_barrier_post((unsigned*)(F.ctl + CW_BAR), F.MISC + 8, F.wave);
#ifdef PROBE_TS
    volatile LAS unsigned long long* TS = (volatile LAS unsigned long long*)(F.lds + MISC_OFF + 128);
    int ts_n = 0;
    volatile LAS unsigned long long* TC = TS + 32;
#define GRID_BAR() do { xcd_barrier(bar); if (tid == 0) { TS[ts_n] = __builtin_amdgcn_s_memrealtime(); TC[ts_n] = (unsigned long long)clock64(); } ++ts_n; } while (0)
    if (tid == 0) { TS[ts_n] = __builtin_amdgcn_s_memrealtime(); TC[ts_n] = (unsigned long long)clock64(); } ++ts_n;
#else
#define GRID_BAR() xcd_barrier(bar)
#endif

    const float* x_in = args.in[0]; const float* c_in = args.in[1]; const float* ctx_in = args.in[2]; const float* cctx_in = args.in[3];
    const float* mod_w = args.in[4]; const float* mod_b = args.in[5]; const float* norm_g = args.in[6];
    unsigned char* WinQ = (unsigned char*)(ws + WS_WIN); float* SW = (float*)(ws + WS_SW); float* SA = (float*)(ws + WS_SA); float* PA = (float*)(ws + WS_PA); float* HN2 = (float*)(ws + WS_HN2); float* EN2 = (float*)(ws + WS_EN2); float* const PAn = nullptr; bf16* WoutT = (bf16*)(ws + WS_WOUT); bf16* WrinT = (bf16*)(ws + WS_WRIN); bf16* WroutT = (bf16*)(ws + WS_WROUT); bf16* WfouT = (bf16*)(ws + WS_WFOU);
    bf16* GW = (bf16*)(ws + WS_GW); bf16* T2 = (bf16*)(ws + WS_T2); bf16* TW = (bf16*)(ws + WS_TW);
    float* MODP = (float*)(ws + WS_MODP); float* MOD = (float*)(ws + WS_MOD);
    unsigned short* XS = (unsigned short*)(ws + WS_XS);     bf16* H = (bf16*)(ws + WS_H); bf16* ACT = (bf16*)(ws + WS_ACT); bf16* Yb = (bf16*)(ws + WS_Y); bf16* YP = (bf16*)(ws + WS_Y + 64 * MiB);
    bf16* YC = (bf16*)(ws + WS_YC); bf16* VC = (bf16*)(ws + WS_VC);
    bf16* Gb = ACT; bf16* Vb = ACT + (size_t)MALL * DM;
    bf16* ZT = ACT; bf16* Fb = ACT + (size_t)BATCH * DM * 4096; bf16* PB = (bf16*)(ws + WS_Y + 64 * MiB);
    const float* MOD0 = MOD; const float* MOD1 = MOD + 9 * NMOD;
#define NG(l, i) (norm_g + ((l) * 6 + (i)) * DM)
#define GREP1(...) __VA_ARGS__
#define GREP2(...) __VA_ARGS__ __VA_ARGS__
#if defined(PROBE_GEMM2)
#define GREP(...) GREP2(__VA_ARGS__)
#else
#define GREP(...) GREP1(__VA_ARGS__)
#endif
#if defined(PROBE_FFNIN2)
#define GREP_IN(...) GREP2(__VA_ARGS__)
#else
#define GREP_IN(...) GREP(__VA_ARGS__)
#endif
#if defined(PROBE_FFNOUT2)
#define GREP_OUT(...) GREP2(__VA_ARGS__)
#else
#define GREP_OUT(...) GREP(__VA_ARGS__)
#endif
    const int cid = (int)blockIdx.x;

    p0_adaln(F, c_in, cctx_in, mod_w, MODP);
    p0_quant_win(F, args.in[7], WinQ, SW);
    { WeightPtrs P{args.in[8], args.in[9], args.in[15], args.in[16], args.in[12], WoutT, WrinT, WroutT, WfouT, GW}; p0_weights(F, P); }
    p0_twiddles(F, T2, TW);
    GRID_BAR();
    p0_adaln_reduce(F, MODP, mod_b, MOD);
    thin_phase<false, true, true, false, false, true, false, true>(F, x_in, ctx_in, nullptr, nullptr, nullptr, H, SA, PAn, nullptr, nullptr, 0, 0.f, NG(0, 0), MOD0, 0, 1, MODP, mod_b);
    GRID_BAR();
    GREP({ pg8::Gemm g{H, (const bf16*)WinQ, DM / 2, DM / 2, DM / 2, 1, 0, 0, 0, 0}; pg8::BatchOrder S; S.init(MALL, 2 * DFF, 1, F.G, cid); pg8::EpiSwiGLU8 E{ACT, DFF, SA, SW};
      pg8::gemm_phase<pg8::EpiSwiGLU8, pg8::BatchOrder, true, true, true>(F.lds + RING_OFF, g, S, E, F.wave); })
    GRID_BAR();
    GREP_OUT({ pg8::Gemm g{ACT, WoutT, 64, DFF, DFF, 1, 0, 0, 0, 0, 32768, (long)(DFF / 64) * 32768}; pg8::BatchOrder S; S.init(MLAT, DM, 1, F.G, cid); pg8::EpiBf16Z E{Yb, DM, 0, 1.0f};
      pg8::gemm_phase<pg8::EpiBf16Z, pg8::BatchOrder, true, true>(F.lds + RING_OFF, g, S, E, F.wave); })
    GREP({ pg8::Gemm g{ACT + (size_t)MLAT * DFF, WoutT, 64, DFF, DFF / 4, 1, (long)(DFF / 4 / 64) * 32768, 0, (DFF / 4) * 2, 0, 32768, (long)(DFF / 64) * 32768}; pg8::BatchOrder S; S.init(MCTX, DM, 4, F.G, cid); pg8::EpiBf16Z E{YC, DM, MCTX, 1.0f};
      pg8::gemm_phase<pg8::EpiBf16Z, pg8::BatchOrder, true, true>(F.lds + RING_OFF, g, S, E, F.wave); })
    GRID_BAR();
    thin_phase<true, true, true, false, true, false>(F, x_in, ctx_in, Yb, YC, XS, H, SA, PAn, NG(0, 1), MOD0, 2, 0.5f, NG(0, 2), MOD0, 3, 4);
    GRID_BAR();
    GREP({ pg8::Gemm g{H, WrinT, DM, DM, DM, 1, 0, 0, 0, 0}; pg8::BatchOrder S; S.init(MLAT, 2 * DM, 1, F.G, cid); pg8::EpiGV E{Gb, Vb, args.in[10], args.in[11]};
      pg8::gemm_phase<pg8::EpiGV, pg8::BatchOrder, true, true>(F.lds + RING_OFF, g, S, E, F.wave); })
    GREP({ pg8::Gemm g{H + (size_t)MLAT * DM, WrinT + (size_t)DM * DM, DM, DM, DM / 4, 1, (DM / 4) * 2, 0, (DM / 4) * 2, 0}; pg8::BatchOrder S; S.init(MCTX, DM, 4, F.G, cid); pg8::EpiBf16Z E{VC, DM, MCTX, 1.0f};
      pg8::gemm_phase<pg8::EpiBf16Z, pg8::BatchOrder, true, true>(F.lds + RING_OFF, g, S, E, F.wave); })
    GRID_BAR();
    scan_phase(F, Vb, VC, Gb, YP, GW, args.in[10], args.in[11], args.in[13], args.in[14]);
    GRID_BAR();
    GREP({ pg8::Gemm g{Gb, WroutT, DM, DM, DM, 1, 0, 0, 0, 0}; pg8::BatchOrder S; S.init(MLAT, DM, 1, F.G, cid); pg8::EpiBf16Z E{Yb, DM, 0, 1.0f};
      pg8::gemm_phase<pg8::EpiBf16Z, pg8::BatchOrder, true, true>(F.lds + RING_OFF, g, S, E, F.wave); })
    GRID_BAR();
    thin_phase<true, true, false, true, true, true>(F, XS, nullptr, Yb, nullptr, XS, H, SA, PAn, NG(0, 3), MOD0, 5, 1.0f, NG(0, 4), MOD0, 6, 7);
    GRID_BAR();
#ifdef PROBE_CLK
    volatile LAS unsigned long long* PC = (volatile LAS unsigned long long*)(F.lds + MISC_OFF + 512);
    if (tid == 0) { PC[0] = (unsigned long long)clock64(); PC[1] = __builtin_amdgcn_s_memrealtime(); }
#endif
    GREP_IN({ pg8::Gemm g{H, (const bf16*)(WinQ + 1 * WIN_ELEMS), DM / 2, DM / 2, DM / 2, 1, 0, 0, 0, 0}; pg8::BatchOrder S; S.init(MLAT, 2 * DFF, 1, F.G, cid); pg8::EpiSwiGLU8 E{ACT, DFF, SA, SW + 1 * 2 * DFF};
      pg8::gemm_phase<pg8::EpiSwiGLU8, pg8::BatchOrder, true, true, true>(F.lds + RING_OFF, g, S, E, F.wave); })
#ifdef PROBE_CLK
    if (tid == 0) { PC[2] = (unsigned long long)clock64(); PC[3] = __builtin_amdgcn_s_memrealtime(); }
#endif
    GRID_BAR();
    GREP_OUT({ pg8::Gemm g{ACT, WoutT + WOUT_ELEMS, 64, DFF, DFF, 1, 0, 0, 0, 0, 32768, (long)(DFF / 64) * 32768}; pg8::BatchOrder S; S.init(MLAT, DM, 1, F.G, cid); pg8::EpiBf16Z E{Yb, DM, 0, 1.0f};
      pg8::gemm_phase<pg8::EpiBf16Z, pg8::BatchOrder, true, true>(F.lds + RING_OFF, g, S, E, F.wave); })
    GRID_BAR();
    thin_phase<true, true, false, true, true, true>(F, XS, nullptr, Yb, nullptr, XS, H, SA, PAn, NG(0, 5), MOD0, 8, 0.5f, NG(1, 0), MOD1, 0, 1);
    GRID_BAR();
    GREP_IN({ pg8::Gemm g{H, (const bf16*)(WinQ + 2 * WIN_ELEMS), DM / 2, DM / 2, DM / 2, 1, 0, 0, 0, 0}; pg8::BatchOrder S; S.init(MLAT, 2 * DFF, 1, F.G, cid); pg8::EpiSwiGLU8 E{ACT, DFF, SA, SW + 2 * 2 * DFF};
      pg8::gemm_phase<pg8::EpiSwiGLU8, pg8::BatchOrder, true, true, true>(F.lds + RING_OFF, g, S, E, F.wave); })
    GRID_BAR();
    GREP_OUT({ pg8::Gemm g{ACT, WoutT + 2 * WOUT_ELEMS, 64, DFF, DFF, 1, 0, 0, 0, 0, 32768, (long)(DFF / 64) * 32768}; pg8::BatchOrder S; S.init(MLAT, DM, 1, F.G, cid); pg8::EpiBf16Z E{Yb, DM, 0, 1.0f};
      pg8::gemm_phase<pg8::EpiBf16Z, pg8::BatchOrder, true, true>(F.lds + RING_OFF, g, S, E, F.wave); })
    GRID_BAR();
    thin_fold_phase(F, XS, Yb, H, PA, HN2, NG(1, 1), MOD1, 2, 0.5f, NG(1, 2), MOD1, 3, 4);
    GRID_BAR();
    for (int bid = (int)blockIdx.x; bid < 64; bid += F.G) {
        const int b = bid >> 3, g = bid & 7; LAS float* A = (LAS float*)F.lds; LAS float* A2 = A + 256; LAS float* CT = A + 512;
        const int tid = F.wave * 64 + lane_now();
        if (tid < 256) { float s = 0.f;
#pragma unroll 8
            for (int j = 0; j < 32; ++j) s += PA[(size_t)(b * 32 + j) * DM + g * 256 + tid];
            A[tid] = s; A2[tid] = HN2[(size_t)b * DM + g * 256 + tid]; CT[tid] = cospif((float)tid * (1.0f / 128.0f)); }
        __syncthreads();
        if (tid < 256) { float s = 0.f, s2 = 0.f;
            for (int c = 0; c < 256; ++c) { const float ct = CT[(tid * c) & 255]; s += ct * A[c]; s2 += ct * A2[c]; }
            Fb[((size_t)b * SEQ + 1024) * DM + g * 256 + tid] = (bf16)f2bf(s * (0.0625f * 0.02209708691207961f));
            EN2[(size_t)b * DM + g * 256 + tid] = s2 * 0.0625f; }
        __syncthreads();
    }
    GREP({ pg8::Gemm g{TW, H, 256, DM, 256, 8, 0, 0, (long)SEQ * DM * 2, 256 * 2}; pg8::ChOrder S; S.init(64, F.G, cid); pg8::EpiZT E{ZT};
      pg8::gemm_phase<pg8::EpiZT, pg8::ChOrder, true, true>(F.lds + RING_OFF, g, S, E, F.wave); })
    GRID_BAR();
    GREP({ pg8::Gemm g{T2, ZT, 2048, 2048, 1024, 1, 0, 0, (long)DM * 2048 * 2, 0}; pg8::BatchOrder S; S.init(1024, DM, 8, F.G, cid); pg8::EpiBf16Z E{PB, DM, 1024, 1.0f};
      pg8::gemm_phase<pg8::EpiBf16Z, pg8::BatchOrder, true, true>(F.lds + RING_OFF, g, S, E, F.wave); })
    VM_WAIT(); __syncthreads();
    GREP({ pg8::Gemm g{T2 + 1024, ZT + 1024, 2048, 2048, 1024, 1, 0, 0, (long)DM * 2048 * 2, 0}; pg8::BatchOrder S; S.init(1024, DM, 8, F.G, cid); pg8::EpiQ E{PB, Fb, EN2, 0.02209708691207961f};
      pg8::gemm_phase<pg8::EpiQ, pg8::BatchOrder, true, true>(F.lds + RING_OFF, g, S, E, F.wave); })
    GRID_BAR();
    GREP({ pg8::Gemm g{Fb, WfouT, DM, DM, DM, 1, 0, 0, 0, 0}; pg8::BatchOrder S; S.init(MLAT, DM, 1, F.G, cid); pg8::EpiBf16Z E{Yb, DM, 0, 1.0f};
      pg8::gemm_phase<pg8::EpiBf16Z, pg8::BatchOrder, true, true>(F.lds + RING_OFF, g, S, E, F.wave); })
    GRID_BAR();
    thin_phase<true, true, false, true, true, true>(F, XS, nullptr, Yb, nullptr, XS, H, SA, PAn, NG(1, 3), MOD1, 5, 1.0f, NG(1, 4), MOD1, 6, 7);
    GRID_BAR();
    GREP_IN({ pg8::Gemm g{H, (const bf16*)(WinQ + 3 * WIN_ELEMS), DM / 2, DM / 2, DM / 2, 1, 0, 0, 0, 0}; pg8::BatchOrder S; S.init(MLAT, 2 * DFF, 1, F.G, cid); pg8::EpiSwiGLU8 E{ACT, DFF, SA, SW + 3 * 2 * DFF};
      pg8::gemm_phase<pg8::EpiSwiGLU8, pg8::BatchOrder, true, true, true>(F.lds + RING_OFF, g, S, E, F.wave); })
    GRID_BAR();
    GREP_OUT({ pg8::Gemm g{ACT, WoutT + 3 * WOUT_ELEMS, 64, DFF, DFF, 1, 0, 0, 0, 0, 32768, (long)(DFF / 64) * 32768}; pg8::BatchOrder S; S.init(MLAT, DM, 1, F.G, cid); pg8::EpiBf16Z E{Yb, DM, 0, 1.0f};
      pg8::gemm_phase<pg8::EpiBf16Z, pg8::BatchOrder, true, true>(F.lds + RING_OFF, g, S, E, F.wave); })
    GRID_BAR();
    thin_phase<true, false, false, true, false, false>(F, XS, nullptr, Yb, nullptr, args.out, nullptr, nullptr, nullptr, NG(1, 5), MOD1, 8, 0.5f, nullptr, nullptr, 0, 0);
#ifdef PROBE_TS
    GRID_BAR();
    if (blockIdx.x == 0 && tid == 0) {
        unsigned long long tot = 0;
        for (int i = 0; i < 23; ++i) if ((PROBE_MASK >> i) & 1u) tot += TS[i + 1] - TS[i];
#ifdef PROBE_MHZ_OF
        tot = ((TC[PROBE_MHZ_OF + 1] - TC[PROBE_MHZ_OF]) * 100ull / (TS[PROBE_MHZ_OF + 1] - TS[PROBE_MHZ_OF])) * 100ull;
#endif
        const unsigned long long t0 = __builtin_amdgcn_s_memrealtime();
        while (__builtin_amdgcn_s_memrealtime() - t0 < tot) __builtin_amdgcn_s_sleep(8);
    }
#endif
#ifdef PROBE_CLK
    if (blockIdx.x == 0 && tid == 0) {
        const unsigned long long dc = PC[2] - PC[0], dr = PC[3] - PC[1];
        const unsigned long long us = PROBE_CLK_WHAT == 0 ? (dc * 100ull) / (dr ? dr : 1ull) : dr / 100ull;
        const unsigned long long t0 = __builtin_amdgcn_s_memrealtime();
        while (__builtin_amdgcn_s_memrealtime() - t0 < us * 100ull) __builtin_amdgcn_s_sleep(8);
    }
#endif
#undef NG
#undef GRID_BAR
}

extern "C" void kernel_launch(void* const* d_in, const int* in_sizes, int n_in, void* d_out, int out_size, void* d_ws, size_t ws_size, hipStream_t stream) {
    static int grid = 0;
    if (grid == 0) {
        if (n_in != 17 || in_sizes[0] != MLAT * DM || out_size != MLAT * DM || ws_size < WS_END) {
            fprintf(stderr, "kernel_launch: unexpected problem (n_in %d, in0 %d, out %d, ws %zu; need ws >= %zu); nothing launched\n", n_in, n_in > 0 ? in_sizes[0] : -1, out_size, ws_size, (size_t)WS_END); grid = -1; return; }
        int dev = 0, cus = 0, per_cu = 0;
        if (hipGetDevice(&dev) != hipSuccess || hipDeviceGetAttribute(&cus, hipDeviceAttributeMultiprocessorCount, dev) != hipSuccess) { fprintf(stderr, "kernel_launch: device query failed\n"); grid = -1; return; }
        if (hipFuncSetAttribute((const void*)fwd_kernel, hipFuncAttributeMaxDynamicSharedMemorySize, LDS_BYTES) != hipSuccess) { fprintf(stderr, "kernel_launch: hipFuncSetAttribute failed\n"); grid = -1; return; }
        if (hipOccupancyMaxActiveBlocksPerMultiprocessor(&per_cu, (const void*)fwd_kernel, NWAVES * 64, LDS_BYTES) != hipSuccess || per_cu < 1)
            fprintf(stderr, "kernel_launch: note: occupancy query reports %d workgroups per CU\n", per_cu);
        (void)hipGetLastError();
        grid = cus < 256 ? cus : 256;
    }
    if (grid < 0) return;
    if (hipMemsetAsync((char*)d_ws + WS_CTL, 0, CTL_ZERO_BYTES, stream) != hipSuccess) { fprintf(stderr, "kernel_launch: hipMemsetAsync failed\n"); return; }
    Args a{};
    for (int i = 0; i < 17; ++i) a.in[i] = (const float*)d_in[i];
    a.out = (float*)d_out; a.ws = (unsigned char*)d_ws;
    hipLaunchKernelGGL(fwd_kernel, dim3(grid), dim3(NWAVES * 64), LDS_BYTES, stream, a);
    const hipError_t le = hipPeekAtLastError();
    if (le != hipSuccess) fprintf(stderr, "kernel_launch: launch failed: %s\n", hipGetErrorName(le));
}
```

```cpp
#include <hip/hip_runtime.h>
#include <cstdio>
#include <cstdint>

namespace pg8 {
#define PG8_LAS __attribute__((address_space(3)))
typedef unsigned short bf16_t;
typedef short bf16x8 __attribute__((ext_vector_type(8)));
typedef float f32x4 __attribute__((ext_vector_type(4)));
typedef unsigned u32x4 __attribute__((ext_vector_type(4)));
typedef int i32x4 __attribute__((ext_vector_type(4)));
constexpr int BM = 256, BK = 64, HALF = 128, HTB = HALF * BK * 2  , STAGE_BYTES = 8 * HTB, NXCD = 8, WGM = 8;

__host__ __device__ __forceinline__ int lds_byte(int r, int c) { const int st = (r >> 4) * 2 + (c >> 5), rr = r & 15, cc = c & 31, ob = rr * 64 + cc * 2; return st * 1024 + (ob ^ (((ob >> 9) & 1) << 5)); }
__host__ __device__ __forceinline__ void stage_rc(int b, int& R, int& C) { const int st = b / 1024, sb = b % 1024, swz = sb ^ (((sb >> 9) & 1) << 5); R = (st >> 1) * 16 + swz / 64; C = (st & 1) * 32 + (swz % 64) / 2; }
__host__ __device__ __forceinline__ int perm32(int rho) { const int n = rho >> 4, i = rho & 15; return 8 * (i >> 2) + 4 * n + (i & 3); }

struct Unit { int pm, pn, z; };
struct Gemm { const bf16_t* A; const bf16_t* Bt; int lda, ldb, K, zdiv; long a_s1, a_s0, b_s1, b_s0; long a_kstep = 0, a_tile = 0;
    __device__ __forceinline__ const char* baseA(const Unit& u) const { return (const char*)A + (long)(u.z / zdiv) * a_s1 + (long)(u.z % zdiv) * a_s0; }
    __device__ __forceinline__ const char* baseB(const Unit& u) const { return (const char*)Bt + (long)(u.z / zdiv) * b_s1 + (long)(u.z % zdiv) * b_s0; } };

struct BatchOrder {
    int nM, nN, per, nwg, G, c;
    __host__ __device__ void init(int M, int N, int nz, int G_, int c_) { nM = M / BM; nN = N / BM; per = nM * nN; nwg = per * nz; G = G_; c = c_; }
    __host__ __device__ bool next(int i, Unit& u) const {
        const long L = (long)i * G + c; if (L >= nwg) return false;
        int wgid = (int)L; { const int q = nwg / NXCD, r = nwg % NXCD, xcd = wgid % NXCD, off = wgid / NXCD; wgid = (xcd < r ? xcd * (q + 1) : r * (q + 1) + (xcd - r) * q) + off; }
        u.z = wgid / per; const int w = wgid % per;
        const int nig = WGM * nN, gid = w / nig, fm = gid * WGM, gsz = (nM - fm) < WGM ? (nM - fm) : WGM;
        u.pm = fm + ((w % nig) % gsz); u.pn = (w % nig) / gsz; return true;
    }
    __device__ __forceinline__ void a_ready(const Unit&) const {}
    __device__ __forceinline__ void done(const Unit&) const {}
};

struct ChOrder {
    int nwg, G, c;
    __host__ __device__ void init(int nz, int G_, int c_) { nwg = nz * 8; G = G_; c = c_; }
    __host__ __device__ bool next(int i, Unit& u) const {
        const long L = (long)i * G + c; if (L >= nwg) return false;
        int wgid = (int)L; { const int q = nwg / NXCD, r = nwg % NXCD, xcd = wgid % NXCD, off = wgid / NXCD; wgid = (xcd < r ? xcd * (q + 1) : r * (q + 1) + (xcd - r) * q) + off; }
        u.z = wgid >> 3; u.pn = wgid & 7; u.pm = u.pn >> 2; return true;
    }
    __device__ __forceinline__ void a_ready(const Unit&) const {}
    __device__ __forceinline__ void done(const Unit&) const {}
};

__device__ __forceinline__ unsigned cvt_pk_bf16(float lo, float hi) { unsigned r; asm volatile("v_cvt_pk_bf16_f32 %0, %1, %2" : "=v"(r) : "v"(lo), "v"(hi)); return r; }
__device__ __forceinline__ float sigmoid_f(float x) { return __builtin_amdgcn_rcpf(1.0f + __builtin_amdgcn_exp2f(-1.4426950408889634f * x)); }
__device__ __forceinline__ float gelu_tanh_f(float x) { return x * sigmoid_f(1.5957691216057308f * (x + 0.044715f * x * x * x)); }

struct EpiF32 {
    static constexpr bool PERM = false, AFTER_DRAIN = false;
    float* C; int ldc; long zs;
    __device__ __forceinline__ void operator()(const f32x4 (&acc)[2][2][4][2], const Unit& u, int wr, int wc, int fr, int fq) const {
        const int row0 = u.pm * BM + wr * 64 + fr, col0 = u.pn * BM + wc * 32 + 4 * fq;
#pragma unroll
        for (int ai = 0; ai < 2; ++ai)
#pragma unroll
            for (int m = 0; m < 4; ++m) { float* rowp = C + (size_t)u.z * zs + (size_t)(row0 + ai * HALF + m * 16) * ldc + col0;
#pragma unroll
                for (int bj = 0; bj < 2; ++bj)
#pragma unroll
                    for (int n = 0; n < 2; ++n) *(f32x4*)(rowp + bj * HALF + n * 16) = acc[ai][bj][m][n]; }
    }
};
struct EpiSwiGLU {
    static constexpr bool PERM = true, AFTER_DRAIN = false;
    bf16_t* O; int ldc;
    __device__ __forceinline__ void operator()(const f32x4 (&acc)[2][2][4][2], const Unit& u, int wr, int wc, int fr, int fq) const {
        const int row0 = u.pm * BM + wr * 64 + fr, col0 = u.pn * HALF + wc * 32 + 8 * fq;
#pragma unroll
        for (int ai = 0; ai < 2; ++ai)
#pragma unroll
            for (int m = 0; m < 4; ++m) { bf16_t* rowp = O + (size_t)(row0 + ai * HALF + m * 16) * ldc + col0;
                float o[8];
#pragma unroll
                for (int n = 0; n < 2; ++n)
#pragma unroll
                    for (int j = 0; j < 4; ++j) { const float gv = acc[ai][0][m][n][j], uv = acc[ai][1][m][n][j]; o[4 * n + j] = gv * sigmoid_f(gv) * uv; }
                u32x4 w; w.x = cvt_pk_bf16(o[0], o[1]); w.y = cvt_pk_bf16(o[2], o[3]); w.z = cvt_pk_bf16(o[4], o[5]); w.w = cvt_pk_bf16(o[6], o[7]);
                *(u32x4*)rowp = w; }
    }
};
struct EpiSwiGLU8 {
    static constexpr bool PERM = true, AFTER_DRAIN = false;
    bf16_t* O; int ldc; const float* sa; const float* sw;
    typedef float f32x2 __attribute__((ext_vector_type(2)));
    __device__ __forceinline__ void operator()(const f32x4 (&acc)[2][2][4][2], const Unit& u, int wr, int wc, int fr, int fq) const {
        const int row0 = u.pm * BM + wr * 64 + fr, col0 = u.pn * HALF + wc * 32 + 8 * fq, wrow0 = u.pn * BM + wc * 32 + 8 * fq;
        f32x4 sg[2], su[2]; float sr[2][4];
#pragma unroll
        for (int n = 0; n < 2; ++n) { sg[n] = *(const f32x4*)(sw + wrow0 + 4 * n); su[n] = *(const f32x4*)(sw + wrow0 + HALF + 4 * n); }
#pragma unroll
        for (int ai = 0; ai < 2; ++ai)
#pragma unroll
            for (int m = 0; m < 4; ++m) sr[ai][m] = sa[row0 + ai * HALF + m * 16];
        f32x2 sgn[4], sgu[4];
#pragma unroll
        for (int p = 0; p < 4; ++p) { const int n = p >> 1, h = 2 * (p & 1); const f32x2 g2 = (f32x2){sg[n][h], sg[n][h + 1]}, u2 = (f32x2){su[n][h], su[n][h + 1]};
            sgn[p] = g2 * -1.4426950408889634f; sgu[p] = g2 * u2; }
#pragma unroll
        for (int ai = 0; ai < 2; ++ai)
#pragma unroll
            for (int m = 0; m < 4; ++m) { const int r = row0 + ai * HALF + m * 16; const float s = sr[ai][m], s2 = s * s; bf16_t* rowp = O + ((((size_t)(r >> 8) * (5632 / 64) + (col0 >> 6)) * 256 + (r & 255)) << 6) + (col0 & 63);
                unsigned wv[4];
#pragma unroll
                for (int p = 0; p < 4; ++p) { const int n = p >> 1, h = 2 * (p & 1);
                    const float g0 = acc[ai][0][m][n][h], g1 = acc[ai][0][m][n][h + 1], u0 = acc[ai][1][m][n][h], u1 = acc[ai][1][m][n][h + 1];
                    const f32x2 gf = (f32x2){(float)__float_as_int(g0), (float)__float_as_int(g1)}, uf = (f32x2){(float)__float_as_int(u0), (float)__float_as_int(u1)};
                    const f32x2 arg = gf * (sgn[p] * s);
                    const f32x2 d = (f32x2){__builtin_amdgcn_exp2f(arg.x), __builtin_amdgcn_exp2f(arg.y)} + 1.0f;
                    const f32x2 rc = (f32x2){__builtin_amdgcn_rcpf(d.x), __builtin_amdgcn_rcpf(d.y)};
                    const f32x2 o = (gf * uf) * ((sgu[p] * s2) * rc);
                    wv[p] = cvt_pk_bf16(o.x, o.y); }
                u32x4 w; w.x = wv[0]; w.y = wv[1]; w.z = wv[2]; w.w = wv[3];
                *(u32x4*)rowp = w; }
    }
};
struct EpiGV {
    static constexpr bool PERM = true, AFTER_DRAIN = false;
    bf16_t* G; bf16_t* V; const float* cw; const float* cb;
    __device__ __forceinline__ void operator()(const f32x4 (&acc)[2][2][4][2], const Unit& u, int wr, int wc, int fr, int fq) const {
        const bool isg = u.pn < 8; bf16_t* base = isg ? G : V;
        const int row0 = u.pm * BM + wr * 64 + fr, col0 = (isg ? u.pn : u.pn - 8) * BM + wc * 32 + 8 * fq;
        if (isg) {
#pragma unroll
            for (int ai = 0; ai < 2; ++ai)
#pragma unroll
                for (int m = 0; m < 4; ++m) { bf16_t* rowp = base + (size_t)(row0 + ai * HALF + m * 16) * 2048 + col0;
#pragma unroll
                    for (int bj = 0; bj < 2; ++bj) { f32x4 v0 = acc[ai][bj][m][0], v1 = acc[ai][bj][m][1];
#pragma unroll
                        for (int j = 0; j < 4; ++j) { v0[j] = gelu_tanh_f(v0[j]); v1[j] = gelu_tanh_f(v1[j]); }
                        u32x4 w; w.x = cvt_pk_bf16(v0[0], v0[1]); w.y = cvt_pk_bf16(v0[2], v0[3]); w.z = cvt_pk_bf16(v1[0], v1[1]); w.w = cvt_pk_bf16(v1[2], v1[3]);
                        *(u32x4*)(rowp + bj * HALF) = w; } }
        } else {
#pragma unroll
            for (int bj = 0; bj < 2; ++bj) {
                f32x4 w[4][2], bb[2];
#pragma unroll
                for (int n = 0; n < 2; ++n) { bb[n] = *(const f32x4*)(cb + col0 + bj * HALF + 4 * n);
#pragma unroll
                    for (int k = 0; k < 4; ++k) w[k][n] = *(const f32x4*)(cw + k * 2048 + col0 + bj * HALF + 4 * n); }
#pragma unroll
                for (int ai = 0; ai < 2; ++ai) {
                    f32x4 o[4][2];
#pragma unroll
                    for (int n = 0; n < 2; ++n)
#pragma unroll
                        for (int j = 0; j < 4; ++j) {
                            float r1[4], r2[4], f1[4];
#pragma unroll
                            for (int m = 0; m < 4; ++m) { const int xi = __float_as_int(acc[ai][bj][m][n][j]);
                                r1[m] = __int_as_float(__builtin_amdgcn_update_dpp(0, xi, 0x121, 0xf, 0xf, false));
                                r2[m] = __int_as_float(__builtin_amdgcn_update_dpp(0, xi, 0x122, 0xf, 0xf, false));
                                f1[m] = __int_as_float(__builtin_amdgcn_update_dpp(0, xi, 0x12f, 0xf, 0xf, false)); }
#pragma unroll
                            for (int m = 0; m < 4; ++m) {
                                const float xm1 = fr >= 1 ? r1[m] : (m > 0 ? r1[m > 0 ? m - 1 : 0] : 0.f);
                                const float xm2 = fr >= 2 ? r2[m] : (m > 0 ? r2[m > 0 ? m - 1 : 0] : 0.f);
                                const float xp1 = fr <= 14 ? f1[m] : (m < 3 ? f1[m < 3 ? m + 1 : 3] : 0.f);
                                o[m][n][j] = bb[n][j] + w[0][n][j] * xm2 + w[1][n][j] * xm1 + w[2][n][j] * acc[ai][bj][m][n][j] + w[3][n][j] * xp1; }
                        }
#pragma unroll
                    for (int m = 0; m < 4; ++m) { bf16_t* rowp = base + (size_t)(row0 + ai * HALF + m * 16) * 2048 + col0 + bj * HALF;
                        u32x4 wv; wv.x = cvt_pk_bf16(o[m][0][0], o[m][0][1]); wv.y = cvt_pk_bf16(o[m][0][2], o[m][0][3]); wv.z = cvt_pk_bf16(o[m][1][0], o[m][1][1]); wv.w = cvt_pk_bf16(o[m][1][2], o[m][1][3]);
                        *(u32x4*)rowp = wv; }
                }
            }
        }
    }
};
struct EpiBf16Z {
    static constexpr bool PERM = true, AFTER_DRAIN = false;
    bf16_t* O; int ldc; int roff_z; float scale;
    __device__ __forceinline__ void operator()(const f32x4 (&acc)[2][2][4][2], const Unit& u, int wr, int wc, int fr, int fq) const {
        const int row0 = u.z * roff_z + u.pm * BM + wr * 64 + fr, col0 = u.pn * BM + wc * 32 + 8 * fq;
#pragma unroll
        for (int ai = 0; ai < 2; ++ai)
#pragma unroll
            for (int m = 0; m < 4; ++m) { bf16_t* rowp = O + (size_t)(row0 + ai * HALF + m * 16) * ldc + col0;
#pragma unroll
                for (int bj = 0; bj < 2; ++bj) { const f32x4 v0 = acc[ai][bj][m][0] * scale, v1 = acc[ai][bj][m][1] * scale;
                    u32x4 w; w.x = cvt_pk_bf16(v0[0], v0[1]); w.y = cvt_pk_bf16(v0[2], v0[3]); w.z = cvt_pk_bf16(v1[0], v1[1]); w.w = cvt_pk_bf16(v1[2], v1[3]);
                    *(u32x4*)(rowp + bj * HALF) = w; } }
    }
};
struct EpiQ {
    static constexpr bool PERM = true, AFTER_DRAIN = false;
    const bf16_t* PB; bf16_t* Fo; const float* En; float scale;
    __device__ __forceinline__ void operator()(const f32x4 (&acc)[2][2][4][2], const Unit& u, int wr, int wc, int fr, int fq) const {
        const int k0 = u.pm * BM + wr * 64 + fr, col0 = u.pn * BM + wc * 32 + 8 * fq;
        float se[2][8];
        { const float sg = (fr & 1) ? -1.0f : 1.0f;
#pragma unroll
          for (int bj = 0; bj < 2; ++bj) { const f32x4 e0 = *(const f32x4*)(En + (size_t)u.z * 2048 + col0 + bj * HALF), e1 = *(const f32x4*)(En + (size_t)u.z * 2048 + col0 + bj * HALF + 4);
              se[bj][0] = sg * e0[0]; se[bj][1] = sg * e0[1]; se[bj][2] = sg * e0[2]; se[bj][3] = sg * e0[3]; se[bj][4] = sg * e1[0]; se[bj][5] = sg * e1[1]; se[bj][6] = sg * e1[2]; se[bj][7] = sg * e1[3]; } }
#pragma unroll
        for (int ai = 0; ai < 2; ++ai) {
            u32x4 pwv[4][2];
#pragma unroll
            for (int m = 0; m < 4; ++m) { const bf16_t* prow = PB + ((size_t)u.z * 1024 + (k0 + ai * HALF + m * 16)) * 2048 + col0;
                pwv[m][0] = *(const u32x4*)prow; pwv[m][1] = *(const u32x4*)(prow + HALF); }
#pragma unroll
            for (int m = 0; m < 4; ++m) { const int k = k0 + ai * HALF + m * 16;
                bf16_t* frow = Fo + ((size_t)u.z * 2048 + k) * 2048 + col0; bf16_t* mrow = Fo + ((size_t)u.z * 2048 + (2048 - k)) * 2048 + col0;
#pragma unroll
                for (int bj = 0; bj < 2; ++bj) { const u32x4 pw = pwv[m][bj]; const f32x4 q0 = acc[ai][bj][m][0], q1 = acc[ai][bj][m][1];
                    const float p[8] = {__uint_as_float(pw.x << 16) + se[bj][0], __uint_as_float(pw.x & 0xffff0000u) + se[bj][1], __uint_as_float(pw.y << 16) + se[bj][2], __uint_as_float(pw.y & 0xffff0000u) + se[bj][3],
                                        __uint_as_float(pw.z << 16) + se[bj][4], __uint_as_float(pw.z & 0xffff0000u) + se[bj][5], __uint_as_float(pw.w << 16) + se[bj][6], __uint_as_float(pw.w & 0xffff0000u) + se[bj][7]};
                    const float q[8] = {q0[0], q0[1], q0[2], q0[3], q1[0], q1[1], q1[2], q1[3]};
                    u32x4 wp, wm;
                    wp.x = cvt_pk_bf16((p[0] + q[0]) * scale, (p[1] + q[1]) * scale); wp.y = cvt_pk_bf16((p[2] + q[2]) * scale, (p[3] + q[3]) * scale);
                    wp.z = cvt_pk_bf16((p[4] + q[4]) * scale, (p[5] + q[5]) * scale); wp.w = cvt_pk_bf16((p[6] + q[6]) * scale, (p[7] + q[7]) * scale);
                    wm.x = cvt_pk_bf16((p[0] - q[0]) * scale, (p[1] - q[1]) * scale); wm.y = cvt_pk_bf16((p[2] - q[2]) * scale, (p[3] - q[3]) * scale);
                    wm.z = cvt_pk_bf16((p[4] - q[4]) * scale, (p[5] - q[5]) * scale); wm.w = cvt_pk_bf16((p[6] - q[6]) * scale, (p[7] - q[7]) * scale);
                    *(u32x4*)(frow + bj * HALF) = wp;
                    if (k > 0) *(u32x4*)(mrow + bj * HALF) = wm; } } }
    }
};
struct EpiZT {
    static constexpr bool PERM = true, AFTER_DRAIN = false;
    bf16_t* ZT;
    __device__ __forceinline__ void operator()(const f32x4 (&acc)[2][2][4][2], const Unit& u, int wr, int wc, int fr, int fq) const {
        const int b = u.z >> 3, g = u.z & 7;
        bf16_t* base = ZT + ((size_t)b * 2048 + (size_t)g * 256) * 2048;
        const int row0 = wr * 64 + fr, col0 = u.pn * BM + wc * 32 + 8 * fq;
#pragma unroll
        for (int ai = 0; ai < 2; ++ai)
#pragma unroll
            for (int m = 0; m < 4; ++m) { bf16_t* rowp = base + (size_t)(row0 + ai * HALF + m * 16) * 2048 + col0;
#pragma unroll
                for (int bj = 0; bj < 2; ++bj) { const f32x4 v0 = acc[ai][bj][m][0] * 0.0625f, v1 = acc[ai][bj][m][1] * 0.0625f;
                    u32x4 w; w.x = cvt_pk_bf16(v0[0], v0[1]); w.y = cvt_pk_bf16(v0[2], v0[3]); w.z = cvt_pk_bf16(v1[0], v1[1]); w.w = cvt_pk_bf16(v1[2], v1[3]);
                    *(u32x4*)(rowp + bj * HALF) = w; } }
    }
};

template <class Epi, class Sched, bool ALIGN_EPI = false, bool SP2 = false, bool I8 = false>
__device__ __forceinline__ void gemm_phase(PG8_LAS unsigned char* lds, const Gemm g, const Sched& S, const Epi& E, const int wave) {
    int tid_; asm volatile("v_mbcnt_lo_u32_b32 %0, -1, 0\n\tv_mbcnt_hi_u32_b32 %0, -1, %0" : "=v"(tid_)); tid_ += wave * 64;
    const int tid = tid_, wid = wave, lane = tid & 63, wr = wid >> 2, wc = wid & 3, fr = lane & 15, fq = lane >> 4;
    const int K = g.K, nt = K / BK;
    unsigned voffA[2], voffB[2];
#pragma unroll
    for (int i = 0; i < 2; ++i) { int R, C; stage_rc(tid * 16 + i * 8192, R, C); const int Rb = Epi::PERM ? ((R & ~31) + perm32(R & 31)) : R;
        voffA[i] = (unsigned)(R * g.lda + C) * 2u; voffB[i] = (unsigned)(Rb * g.ldb + C) * 2u; }
    const size_t kstep = (size_t)(BK * 2);
    const size_t kstepA = g.a_kstep ? (size_t)g.a_kstep : kstep;
    const size_t hA = (size_t)HALF * g.lda * 2, hB = (size_t)HALF * g.ldb * 2;
    const size_t tA = g.a_tile ? (size_t)g.a_tile : 2 * hA, tB = 2 * hB;
    const unsigned ldsw = (unsigned)wid * 1024u;
    const int aoff = lds_byte(wr * 64 + fr, fq * 8), boff = lds_byte(wc * 32 + fr, fq * 8);
#define PG8_SA(b, h) (((b) * 2 + (h)) * HTB)
#define PG8_SB(b, h) ((4 + (b) * 2 + (h)) * HTB)
#define PG8_STAGE(bufoff, gbase, voff) do { _Pragma("unroll") for (int _i = 0; _i < 2; ++_i) \
        __builtin_amdgcn_global_load_lds((const unsigned*)((const char*)(gbase) + (voff)[_i]), (PG8_LAS unsigned*)(lds + (bufoff) + ldsw + _i * 8192), 16, 0, 0); } while (0)
#define PG8_LDA(dst, b, h) do { _Pragma("unroll") for (int m = 0; m < 4; ++m) _Pragma("unroll") for (int k = 0; k < 2; ++k) dst[m][k] = *(const PG8_LAS bf16x8*)(lds + PG8_SA(b, h) + aoff + m * 2048 + k * 1024); } while (0)
#define PG8_LDB(dst, b, h) do { _Pragma("unroll") for (int n = 0; n < 2; ++n) _Pragma("unroll") for (int k = 0; k < 2; ++k) dst[n][k] = *(const PG8_LAS bf16x8*)(lds + PG8_SB(b, h) + boff + n * 2048 + k * 1024); } while (0)
#define PG8_MMA(ai, bj, At, Bt) do { __builtin_amdgcn_s_setprio(1); _Pragma("unroll") for (int m = 0; m < 4; ++m) _Pragma("unroll") for (int n = 0; n < 2; ++n) _Pragma("unroll") for (int k = 0; k < 2; ++k) \
        { if constexpr (I8) acc[ai][bj][m][n] = __builtin_bit_cast(f32x4, __builtin_amdgcn_mfma_i32_16x16x64_i8(__builtin_bit_cast(i32x4, Bt[n][k]), __builtin_bit_cast(i32x4, At[m][k]), __builtin_bit_cast(i32x4, acc[ai][bj][m][n]), 0, 0, 0)); \
          else acc[ai][bj][m][n] = __builtin_amdgcn_mfma_f32_16x16x32_bf16(Bt[n][k], At[m][k], acc[ai][bj][m][n], 0, 0, 0); } __builtin_amdgcn_s_setprio(0); } while (0)
#define PG8_WAIT_V(n) asm volatile("s_waitcnt vmcnt(" #n ")" ::: "memory")
#define PG8_WAIT_L(n) asm volatile("s_waitcnt lgkmcnt(" #n ")" ::: "memory")
#define PG8_BAR __builtin_amdgcn_s_barrier()
#define PG8_SCHED __builtin_amdgcn_sched_barrier(0)
    Unit cur, nxt; int ui = 0;
    if (!S.next(0, cur)) return;
    f32x4 acc[2][2][4][2];
#pragma unroll
    for (int a = 0; a < 2; ++a)
#pragma unroll
        for (int b = 0; b < 2; ++b)
#pragma unroll
            for (int m = 0; m < 4; ++m)
#pragma unroll
                for (int n = 0; n < 2; ++n) acc[a][b][m][n] = (f32x4){0.f, 0.f, 0.f, 0.f};
    bf16x8 At[4][2], B0[2][2], B1[2][2];
    const char* cA = g.baseA(cur) + (size_t)cur.pm * tA; const char* cB = g.baseB(cur) + (size_t)cur.pn * tB;
    S.a_ready(cur);
    if constexpr (SP2) {
        PG8_STAGE(PG8_SB(0, 0), cB, voffB); PG8_STAGE(PG8_SB(0, 1), cB + hB, voffB); PG8_STAGE(PG8_SA(0, 0), cA, voffA); PG8_STAGE(PG8_SA(0, 1), cA + hA, voffA);
        if (wr == 1) PG8_BAR;
        PG8_WAIT_V(2); PG8_BAR;
        PG8_STAGE(PG8_SB(1, 0), cB + kstep, voffB); PG8_STAGE(PG8_SA(1, 0), cA + kstepA, voffA); PG8_STAGE(PG8_SB(1, 1), cB + hB + kstep, voffB);
        PG8_WAIT_V(6); PG8_BAR;
    } else {
        PG8_STAGE(PG8_SB(0, 0), cB, voffB); PG8_STAGE(PG8_SA(0, 0), cA, voffA); PG8_STAGE(PG8_SB(0, 1), cB + hB, voffB); PG8_STAGE(PG8_SA(0, 1), cA + hA, voffA);
        if (wr == 1) PG8_BAR;
        PG8_WAIT_V(4); PG8_BAR;
        PG8_STAGE(PG8_SB(1, 0), cB + kstep, voffB); PG8_STAGE(PG8_SA(1, 0), cA + kstepA, voffA); PG8_STAGE(PG8_SB(1, 1), cB + hB + kstep, voffB);
        PG8_WAIT_V(6); PG8_BAR;
    }
    for (;;) {
        const bool has_next = S.next(ui + 1, nxt);
        const char* nA = has_next ? g.baseA(nxt) + (size_t)nxt.pm * tA : cA; const char* nB = has_next ? g.baseB(nxt) + (size_t)nxt.pn * tB : cB;
        for (int t = 0; t < nt; t += 2) {
            const bool last = (t == nt - 2);
            const char* a1 = cA + (size_t)(t + 1) * kstepA;
            const char* a2 = last ? nA : cA + (size_t)(t + 2) * kstepA; const char* b2 = last ? nB : cB + (size_t)(t + 2) * kstep;
            const char* a3 = a2 + kstepA; const char* b3 = b2 + kstep;
            if (last && has_next) S.a_ready(nxt);
            if constexpr (SP2) {
            PG8_LDB(B0, 0, 0); PG8_LDB(B1, 0, 1); PG8_SCHED; PG8_LDA(At, 0, 0); PG8_STAGE(PG8_SA(1, 1), a1 + hA, voffA);
            PG8_WAIT_V(8); PG8_WAIT_L(0); PG8_BAR; PG8_MMA(0, 0, At, B0); PG8_MMA(0, 1, At, B1); PG8_BAR; PG8_SCHED;
            PG8_LDA(At, 0, 1); PG8_STAGE(PG8_SB(0, 0), b2, voffB); PG8_STAGE(PG8_SB(0, 1), b2 + hB, voffB); PG8_STAGE(PG8_SA(0, 0), a2, voffA);
            PG8_WAIT_V(8); PG8_WAIT_L(0); PG8_BAR; PG8_MMA(1, 0, At, B0); PG8_MMA(1, 1, At, B1); PG8_BAR; PG8_SCHED;
            PG8_LDB(B0, 1, 0); PG8_LDB(B1, 1, 1); PG8_SCHED; PG8_LDA(At, 1, 0); PG8_STAGE(PG8_SA(0, 1), a2 + hA, voffA);
            PG8_WAIT_V(8); PG8_WAIT_L(0); PG8_BAR; PG8_MMA(0, 0, At, B0); PG8_MMA(0, 1, At, B1); PG8_BAR; PG8_SCHED;
            PG8_LDA(At, 1, 1); PG8_STAGE(PG8_SB(1, 0), b3, voffB); PG8_STAGE(PG8_SB(1, 1), b3 + hB, voffB); PG8_STAGE(PG8_SA(1, 0), a3, voffA);
            PG8_WAIT_V(8); PG8_WAIT_L(0); PG8_BAR; PG8_MMA(1, 0, At, B0); PG8_MMA(1, 1, At, B1); PG8_BAR; PG8_SCHED;
            } else {
            PG8_LDB(B0, 0, 0); PG8_SCHED; PG8_LDA(At, 0, 0); PG8_STAGE(PG8_SA(1, 1), a1 + hA, voffA);
            PG8_WAIT_L(8); PG8_BAR; PG8_WAIT_L(0); PG8_MMA(0, 0, At, B0); PG8_BAR; PG8_SCHED;
            PG8_LDB(B1, 0, 1); PG8_STAGE(PG8_SB(0, 0), b2, voffB);
            PG8_BAR; PG8_WAIT_L(0); PG8_MMA(0, 1, At, B1); PG8_BAR;
            PG8_LDA(At, 0, 1); PG8_STAGE(PG8_SA(0, 0), a2, voffA);
            PG8_BAR; PG8_WAIT_L(0); PG8_MMA(1, 0, At, B0); PG8_BAR; PG8_SCHED;
            PG8_STAGE(PG8_SB(0, 1), b2 + hB, voffB);
            PG8_WAIT_V(6); PG8_BAR; PG8_MMA(1, 1, At, B1); PG8_BAR;
            PG8_LDB(B0, 1, 0); PG8_SCHED; PG8_LDA(At, 1, 0); PG8_STAGE(PG8_SA(0, 1), a2 + hA, voffA);
            PG8_WAIT_L(8); PG8_BAR; PG8_WAIT_L(0); PG8_MMA(0, 0, At, B0); PG8_BAR; PG8_SCHED;
            PG8_LDB(B1, 1, 1); PG8_STAGE(PG8_SB(1, 0), b3, voffB);
            PG8_BAR; PG8_WAIT_L(0); PG8_MMA(0, 1, At, B1); PG8_BAR;
            PG8_LDA(At, 1, 1); PG8_STAGE(PG8_SA(1, 0), a3, voffA);
            PG8_BAR; PG8_WAIT_L(0); PG8_MMA(1, 0, At, B0); PG8_BAR; PG8_SCHED;
            PG8_STAGE(PG8_SB(1, 1), b3 + hB, voffB);
            PG8_WAIT_V(6); PG8_BAR; PG8_MMA(1, 1, At, B1); PG8_BAR;
            }
        }
        if constexpr (ALIGN_EPI) { if (wr == 0) PG8_BAR; }
        if constexpr (!Epi::AFTER_DRAIN) { E(acc, cur, wr, wc, fr, fq); S.done(cur); }
        if (!has_next) break;
#pragma unroll
        for (int a = 0; a < 2; ++a)
#pragma unroll
            for (int b = 0; b < 2; ++b)
#pragma unroll
                for (int m = 0; m < 4; ++m)
#pragma unroll
                    for (int n = 0; n < 2; ++n) acc[a][b][m][n] = (f32x4){0.f, 0.f, 0.f, 0.f};
        cur = nxt; cA = nA; cB = nB; ++ui;
        if constexpr (ALIGN_EPI) { if (wr == 1) PG8_BAR; }
    }
    PG8_WAIT_V(0);
    if constexpr (!ALIGN_EPI) { if (wr == 0) PG8_BAR; }
    PG8_BAR;
    if constexpr (Epi::AFTER_DRAIN) { E.fused(acc, cur, wr, wc, fr, fq, lds, wid, lane); S.done(cur); }
#undef PG8_SA
#undef PG8_SB
#undef PG8_STAGE
#undef PG8_LDA
#undef PG8_LDB
#undef PG8_MMA
#undef PG8_WAIT_V
#undef PG8_WAIT_L
#undef PG8_BAR
#undef PG8_SCHED
}
}

constexpr int NWAVES = 8;
constexpr int DM = 2048, BATCH = 8, SEQ = 2048, CTXL = 256, DFF = 5632, NMOD = 9 * DM;
constexpr int MLAT = BATCH * SEQ, MCTX = BATCH * CTXL, MALL = MLAT + MCTX;
constexpr float EPS = 1e-6f;

constexpr size_t MiB = 1u << 20;
constexpr size_t WS_CTL = 0, CTL_ZERO_BYTES = 1 * MiB;
constexpr size_t WS_WIN = 1 * MiB;
constexpr size_t WS_WOUT = 177 * MiB;
constexpr size_t WS_WRIN = 265 * MiB;
constexpr size_t WS_WROUT = 281 * MiB;
constexpr size_t WS_WFOU = 289 * MiB;
constexpr size_t WS_GW = 297 * MiB;
constexpr size_t WS_T2 = 299 * MiB;
constexpr size_t WS_TW = 315 * MiB;
constexpr size_t WS_MOD = 322 * MiB;
constexpr size_t WS_XS = 324 * MiB;
constexpr size_t WS_H = 468 * MiB;
constexpr size_t WS_ACT = 540 * MiB;
constexpr size_t WS_Y = 738 * MiB;
constexpr size_t WS_MODP = 882 * MiB;
constexpr size_t WS_YC = 894 * MiB;
constexpr size_t WS_VC = 958 * MiB;
constexpr size_t WS_SW = 1022 * MiB;
constexpr size_t WS_SA = 1023 * MiB;
constexpr size_t WS_PA = 1024 * MiB;
constexpr size_t WS_HN2 = 1026 * MiB;
constexpr size_t WS_EN2 = WS_HN2 + 65536;
constexpr size_t WS_END = 1027 * MiB;
constexpr size_t CSL = (size_t)MCTX * DM;
constexpr size_t WIN_ELEMS = (size_t)2 * DFF * DM, WOUT_ELEMS = (size_t)DM * DFF;
constexpr int CW_BAR = 4096;

constexpr int RING_OFF = 0, RING_BYTES = 131072;
constexpr int LDSCTL_OFF = 143360, MISC_OFF = LDSCTL_OFF + 320;
constexpr int LDS_BYTES = 147456;

#define GAS __attribute__((address_space(1)))
#define LAS __attribute__((address_space(3)))
typedef unsigned short bf16;
typedef unsigned v4u __attribute__((ext_vector_type(4)));
typedef unsigned v2u __attribute__((ext_vector_type(2)));
typedef float f32x4 __attribute__((ext_vector_type(4)));
typedef short bf16x8 __attribute__((ext_vector_type(8)));
typedef GAS unsigned gu32;
#define RLX_AGENT __ATOMIC_RELAXED, __HIP_MEMORY_SCOPE_AGENT
#define LDS_WAIT() asm volatile("s_waitcnt lgkmcnt(0)" ::: "memory")
#define VM_WAIT() asm volatile("s_waitcnt vmcnt(0)" ::: "memory")
__device__ __forceinline__ unsigned f2bf(float f) { unsigned u = __builtin_bit_cast(unsigned, f); return (u + 0x7fffu + ((u >> 16) & 1u)) >> 16; }
__device__ __forceinline__ unsigned pk2(float lo, float hi) { return pg8::cvt_pk_bf16(lo, hi); }
typedef _Float16 h16x2 __attribute__((ext_vector_type(2)));
__device__ __forceinline__ unsigned pkh2(float lo, float hi) { h16x2 v; v.x = (_Float16)lo; v.y = (_Float16)hi; return __builtin_bit_cast(unsigned, v); }
__device__ __forceinline__ float h_lo(unsigned w) { return (float)__builtin_bit_cast(h16x2, w).x; }
__device__ __forceinline__ float h_hi(unsigned w) { return (float)__builtin_bit_cast(h16x2, w).y; }
__device__ __forceinline__ float bf_lo(unsigned w) { return __uint_as_float(w << 16); }
__device__ __forceinline__ float bf_hi(unsigned w) { return __uint_as_float(w & 0xffff0000u); }

__device__ __forceinline__ int lane_now() { int l; asm volatile("v_mbcnt_lo_u32_b32 %0, -1, 0\n\tv_mbcnt_hi_u32_b32 %0, -1, %0" : "=v"(l)); return l; }
#define XB_TMO      128
#define XB_XCNT(j)  (256  + 64 * (j))
#define XB_XSUB(j)  (1280 + 64 * (j))
#define XB_XGEN(j)  (2304 + 64 * (j))
#define XB_TOP      3328
#define XB_TOPGEN   3392
#define XCD_BAR_WORDS 3456
#define XB_SPIN_CAP (1u << 18)

__device__ __forceinline__ unsigned xb_ld(unsigned* p)              { return __hip_atomic_load(p, __ATOMIC_RELAXED, __HIP_MEMORY_SCOPE_AGENT); }
__device__ __forceinline__ unsigned xb_add(unsigned* p, unsigned v) { return __hip_atomic_fetch_add(p, v, __ATOMIC_RELAXED, __HIP_MEMORY_SCOPE_AGENT); }
__device__ __forceinline__ unsigned xb_xcc_id() { return (unsigned)__builtin_amdgcn_s_getreg((3 << 11) | 20) & 0xFu; }
#define XB_SPIN(cond, bar) do { unsigned _sp = 0; while (cond) { __builtin_amdgcn_s_sleep(1); \
    if ((++_sp & 255u) == 0u) { if (xb_ld(&(bar)[XB_TMO])) break; if (_sp > XB_SPIN_CAP) { atomicAdd(&(bar)[XB_TMO], 1u); break; } } } } while (0)

struct XcdBarrier {
    unsigned* bar; unsigned x; int wave;
    volatile LAS unsigned* st;
};
__device__ __forceinline__ XcdBarrier xcd_barrier_post(unsigned* bar, volatile LAS unsigned* st, int wave) {
    XcdBarrier b; b.bar = bar; b.x = xb_xcc_id(); b.st = st; b.wave = wave;
    if (wave == 0 && lane_now() == 0) (void)xb_add(&bar[XB_XCNT(b.x)], 1u);
    return b;
}
__device__ __forceinline__ void xcd_barrier_complete(unsigned* bar, unsigned x, unsigned& nloc, unsigned& nx) {
    const unsigned G = gridDim.x * gridDim.y * gridDim.z;
    unsigned sum, cnt, mine, sp = 0u;
    for (;;) {
        sum = 0u; cnt = 0u; mine = 0u;
#pragma unroll
        for (unsigned j = 0; j < 16; ++j) { const unsigned c = xb_ld(&bar[XB_XCNT(j)]); sum += c; cnt += (c > 0u) ? 1u : 0u; mine = (j == x) ? c : mine; }
        if (sum == G) break;
        __builtin_amdgcn_s_sleep(1);
        if ((++sp & 255u) == 0u) { if (xb_ld(&bar[XB_TMO])) break; if (sp > XB_SPIN_CAP) { atomicAdd(&bar[XB_TMO], 1u); break; } }
    }
    nloc = mine > 0u ? mine : 1u; nx = cnt > 0u ? cnt : 1u;
}
__device__ __forceinline__ void xcd_barrier(const XcdBarrier& b) {
    asm volatile("s_waitcnt vmcnt(0)" ::: "memory");
    __syncthreads();
    if (b.wave == 0 && lane_now() == 0) {
        unsigned* bar = b.bar;
        __builtin_amdgcn_s_waitcnt(0);
        unsigned nloc = b.st[0], nx = b.st[1];
        if (nloc == 0u) { xcd_barrier_complete(bar, b.x, nloc, nx); b.st[0] = nloc; b.st[1] = nx; }
        const unsigned old = xb_add(&bar[XB_XSUB(b.x)], 1u);
        const unsigned gen = old / nloc;
        if (old + 1u == (gen + 1u) * nloc) {
            __builtin_amdgcn_fence(__ATOMIC_RELEASE, "agent");
            asm volatile("s_waitcnt vmcnt(0)" ::: "memory");
            const unsigned og = xb_add(&bar[XB_TOP], 1u);
            const unsigned tg = og / nx;
            if (og + 1u == (tg + 1u) * nx) xb_add(&bar[XB_TOPGEN], 1u);
            else XB_SPIN(xb_ld(&bar[XB_TOPGEN]) == tg, bar);
            __builtin_amdgcn_fence(__ATOMIC_ACQUIRE, "agent");
            xb_add(&bar[XB_XGEN(b.x)], 1u);
            asm volatile("s_waitcnt vmcnt(0)" ::: "memory");
        } else {
            XB_SPIN(xb_ld(&bar[XB_XGEN(b.x)]) == gen, bar);
            __builtin_amdgcn_fence(__ATOMIC_ACQUIRE, "agent");
            asm volatile("s_waitcnt vmcnt(0)" ::: "memory");
        }
    }
    __syncthreads();
}

struct Frame {
    LAS unsigned char* lds;
    volatile LAS unsigned* MISC;
    gu32* ctl;
    int wave, G;
};
__device__ __forceinline__ float wave_sum(float v) {
#pragma unroll
    for (int o = 1; o < 64; o <<= 1) v += __shfl_xor(v, o);
    return v;
}

__device__ __forceinline__ void p0_adaln(Frame& F, const float* c, const float* cctx, const float* mod_w, float* MODP) {
    const int lane = lane_now(), tid = F.wave * 64 + lane; (void)tid; (void)lane;
    LAS float* S = (LAS float*)F.lds;
    LAS float* RED = S + 9 * 256;
    for (int it = blockIdx.x; it < 2 * 8 * 72; it += F.G) {
        const int l = it / 576, rem = it % 576, kb = rem / 72, cg = rem % 72;
        __syncthreads();
        for (int i = tid; i < 9 * 256; i += NWAVES * 64) { const int r = i >> 8, k = i & 255; const float cv = (r < 8) ? c[r * DM + kb * 256 + k] : cctx[kb * 256 + k]; S[i] = cv / (1.0f + __expf(-cv)); }
        __syncthreads();
        f32x4 acc[9];
#pragma unroll
        for (int r = 0; r < 9; ++r) acc[r] = (f32x4){0.f, 0.f, 0.f, 0.f};
        const float* W = mod_w + ((size_t)l * DM + kb * 256 + F.wave * 32) * NMOD + cg * 256 + lane * 4;
        f32x4 w[8], wn[8];
#pragma unroll
        for (int e = 0; e < 8; ++e) w[e] = __builtin_nontemporal_load((const f32x4*)(W + (size_t)e * NMOD));
#pragma unroll
        for (int k = 0; k < 32; k += 8) {
            if (k + 8 < 32) {
#pragma unroll
                for (int e = 0; e < 8; ++e) wn[e] = __builtin_nontemporal_load((const f32x4*)(W + (size_t)(k + 8 + e) * NMOD)); }
#pragma unroll
            for (int r = 0; r < 9; ++r) { const f32x4 s0 = *(const LAS f32x4*)(S + r * 256 + F.wave * 32 + k), s1 = *(const LAS f32x4*)(S + r * 256 + F.wave * 32 + k + 4);
                acc[r] += w[0] * s0.x + w[1] * s0.y + w[2] * s0.z + w[3] * s0.w + w[4] * s1.x + w[5] * s1.y + w[6] * s1.z + w[7] * s1.w; }
            if (k + 8 < 32) {
#pragma unroll
                for (int e = 0; e < 8; ++e) w[e] = wn[e]; }
        }
#pragma unroll
        for (int r = 0; r < 9; ++r) *(LAS f32x4*)(RED + (F.wave * 9 + r) * 256 + lane * 4) = acc[r];
        __syncthreads();
        for (int i = tid; i < 9 * 256; i += NWAVES * 64) { const int r = i >> 8, cc = i & 255; float s = 0.f;
#pragma unroll
            for (int w = 0; w < 8; ++w) s += RED[(w * 9 + r) * 256 + cc];
            MODP[((size_t)(l * 8 + kb) * 9 + r) * NMOD + cg * 256 + cc] = s; }
    }
    __syncthreads();
}
__device__ __forceinline__ void p0_adaln_reduce(Frame& F, const float* MODP, const float* mod_b, float* MOD) {
    const int lane = lane_now(), tid = F.wave * 64 + lane; (void)tid; (void)lane;
    for (int i = blockIdx.x * (NWAVES * 64) + tid; i < 2 * 9 * NMOD; i += F.G * NWAVES * 64) {
        const int l = i / (9 * NMOD), rn = i % (9 * NMOD), n = rn % NMOD;
        float s = mod_b[l * NMOD + n];
#pragma unroll
        for (int kb = 0; kb < 8; ++kb) s += MODP[(size_t)(l * 8 + kb) * 9 * NMOD + rn];
        MOD[i] = s;
    }
}

__device__ __forceinline__ void p0_transpose_load(f32x4 (&v)[8], const float* W, int N, int k0, int n0, int lane) {
    const int kr = lane >> 3, n4 = lane & 7;
#pragma unroll
    for (int i = 0; i < 8; ++i) v[i] = __builtin_nontemporal_load((const f32x4*)(W + (size_t)(k0 + kr + 8 * i) * N + n0 + 4 * n4));
}
__device__ __forceinline__ void p0_transpose_store(const f32x4 (&v)[8], bf16* WT, int ldt, int dst_row0, LAS float* scr, int k0, int lane) {
    const int kr = lane >> 3, n4 = lane & 7;
#pragma unroll
    for (int i = 0; i < 8; ++i) { LAS float* d = scr + (kr + 8 * i) * 33 + 4 * n4; d[0] = v[i].x; d[1] = v[i].y; d[2] = v[i].z; d[3] = v[i].w; }
    LDS_WAIT(); asm volatile("" ::: "memory");
    const int c = lane & 7;
#pragma unroll
    for (int j = 0; j < 4; ++j) { const int n = (lane >> 3) + 8 * j; const LAS float* s = scr + (8 * c) * 33 + n;
        v4u o; o.x = pk2(s[0 * 33], s[1 * 33]); o.y = pk2(s[2 * 33], s[3 * 33]); o.z = pk2(s[4 * 33], s[5 * 33]); o.w = pk2(s[6 * 33], s[7 * 33]);
        *(GAS v4u*)(WT + (size_t)(dst_row0 + n) * ldt + k0 + 8 * c) = o; }
    LDS_WAIT(); asm volatile("" ::: "memory");
}
__device__ __forceinline__ void p0_quant_win(Frame& F, const float* ffn_in, unsigned char* WinQ, float* SW) {
    const int lane = lane_now(), tid = F.wave * 64 + lane; (void)lane;
    LAS unsigned char* Q = F.lds;
    LAS float* red = (LAS float*)(F.lds + 32 * 2064);
    LAS float* inv = red + 64 * 32;
    const int n4 = tid & 7, kq = tid >> 3;
    __syncthreads();
    for (int it = F.G - 1 - (int)blockIdx.x; it < 4 * 352; it += F.G) {
        const int mi = it / 352, n0 = 32 * (it % 352);
        const int s = n0 / DFF, f = n0 % DFF, drow = 256 * (f / 128) + 128 * s + (f % 128);
        const float* W = ffn_in + (size_t)mi * DM * 2 * DFF + n0 + 4 * n4;
        f32x4 v[8][4]; f32x4 mx = (f32x4){0.f, 0.f, 0.f, 0.f};
#pragma unroll
        for (int i = 0; i < 8; ++i)
#pragma unroll
            for (int e = 0; e < 4; ++e) v[i][e] = __builtin_nontemporal_load((const f32x4*)(W + (size_t)(256 * i + 4 * kq + e) * (2 * DFF)));
#pragma unroll
        for (int i = 0; i < 8; ++i)
#pragma unroll
            for (int e = 0; e < 4; ++e) { mx.x = fmaxf(mx.x, fabsf(v[i][e].x)); mx.y = fmaxf(mx.y, fabsf(v[i][e].y)); mx.z = fmaxf(mx.z, fabsf(v[i][e].z)); mx.w = fmaxf(mx.w, fabsf(v[i][e].w)); }
        *(LAS f32x4*)(red + kq * 32 + 4 * n4) = mx;
        __syncthreads();
        if (tid < 32) { float m = 0.f;
#pragma unroll 8
            for (int r = 0; r < 64; ++r) m = fmaxf(m, red[r * 32 + tid]);
            SW[(size_t)mi * 2 * DFF + drow + tid] = m > 0.f ? m * (1.0f / 127.0f) : 1.0f; inv[tid] = m > 0.f ? 127.0f / m : 0.f; }
        __syncthreads();
        const f32x4 iv = *(const LAS f32x4*)(inv + 4 * n4);
#pragma unroll
        for (int i = 0; i < 8; ++i)
#pragma unroll
            for (int c = 0; c < 4; ++c) { unsigned p = 0u;
#pragma unroll
                for (int e = 0; e < 4; ++e) p |= ((unsigned)(int)__builtin_rintf(v[i][e][c] * iv[c]) & 0xffu) << (8 * e);
                *(LAS unsigned*)(Q + (4 * n4 + c) * 2064 + 256 * i + 4 * kq) = p; }
        __syncthreads();
        { const int row = tid >> 4, seg = tid & 15;
#pragma unroll
          for (int j = 0; j < 8; ++j) *(GAS v4u*)(WinQ + ((size_t)mi * 2 * DFF + drow + row) * DM + 16 * (seg + 16 * j)) = *(const LAS v4u*)(Q + row * 2064 + 16 * (seg + 16 * j)); }
        __syncthreads();
    }
}
struct WeightPtrs { const float *ffn_out, *rec_in, *rec_out, *fou_out, *gate_w; bf16 *WoutT, *WrinT, *WroutT, *WfouT, *GW; };
__device__ __forceinline__ void p0_weights(Frame& F, const WeightPtrs& P) {
    const int lane = lane_now(), tid = F.wave * 64 + lane; (void)tid; (void)lane;
    LAS float* scr = (LAS float*)(F.lds + RING_OFF + F.wave * 16384);
    const int gw = blockIdx.x * NWAVES + F.wave, NGW = F.G * NWAVES;
    constexpr int I_OUT = (DFF / 64) * (DM / 32), I_RIN = (DM / 64) * (2 * DM / 32), I_SQ = (DM / 64) * (DM / 32), I_G = 2 * 4;
    constexpr int NITEMS = 4 * I_OUT + I_RIN + 2 * I_SQ + 64 * I_G;
#define P0_ITEM(it_, W_, N_, WT_, ldt_, drow_, k0_, n0_) do { int r_ = (it_); \
        if (r_ < 4 * I_OUT) { const int mi = r_ / I_OUT, q = r_ % I_OUT, nblk = DM / 32; W_ = P.ffn_out + (size_t)mi * DFF * DM; N_ = DM; WT_ = P.WoutT + (size_t)mi * WOUT_ELEMS; ldt_ = DFF; k0_ = 64 * (q / nblk); n0_ = 32 * (q % nblk); } \
        else if ((r_ -= 4 * I_OUT) < I_RIN) { const int nblk = 2 * DM / 32; W_ = P.rec_in; N_ = 2 * DM; WT_ = P.WrinT; ldt_ = DM; k0_ = 64 * (r_ / nblk); n0_ = 32 * (r_ % nblk); } \
        else if ((r_ -= I_RIN) < 2 * I_SQ) { const int mi = r_ / I_SQ, q = r_ % I_SQ, nblk = DM / 32; W_ = mi ? P.fou_out : P.rec_out; N_ = DM; WT_ = mi ? P.WfouT : P.WroutT; ldt_ = DM; k0_ = 64 * (q / nblk); n0_ = 32 * (q % nblk); } \
        else { r_ -= 2 * I_SQ; const int mi = r_ / I_G, q = r_ % I_G; W_ = P.gate_w + (size_t)mi * 128 * 128; N_ = 128; WT_ = P.GW + (size_t)mi * 128 * 128; ldt_ = 128; k0_ = 64 * (q / 4); n0_ = 32 * (q % 4); } \
        drow_ = n0_; } while (0)
    const float* Wc; bf16* WTc; int Nc, ldc, drc, k0c, n0c; f32x4 vc[8];
    int it = gw;
    if (it < NITEMS) { P0_ITEM(it, Wc, Nc, WTc, ldc, drc, k0c, n0c); p0_transpose_load(vc, Wc, Nc, k0c, n0c, lane); }
    while (it < NITEMS) {
        const int nx = it + NGW; const float* Wn = Wc; bf16* WTn = WTc; int Nn = Nc, ldn = ldc, drn = drc, k0n = k0c, n0n = n0c; f32x4 vn[8];
        if (nx < NITEMS) { P0_ITEM(nx, Wn, Nn, WTn, ldn, drn, k0n, n0n); p0_transpose_load(vn, Wn, Nn, k0n, n0n, lane); }
        p0_transpose_store(vc, WTc, ldc, drc, scr, k0c, lane);
        if (nx < NITEMS) {
#pragma unroll
            for (int i = 0; i < 8; ++i) vc[i] = vn[i];
            Wc = Wn; WTc = WTn; Nc = Nn; ldc = ldn; drc = drn; k0c = k0n; n0c = n0n; }
        it = nx;
    }
#undef P0_ITEM
}
__device__ __forceinline__ void p0_twiddles(Frame& F, bf16* T2, bf16* TW) {
    const int lane = lane_now(), tid = F.wave * 64 + lane; (void)tid; (void)lane;
    const int gt = blockIdx.x * (NWAVES * 64) + tid, NGT = F.G * NWAVES * 64;
    for (int i = gt; i < 1024 * 2048 / 8; i += NGT) {
        const int k1 = i >> 8, col = (i & 255) * 8, cs = col >> 10, n0 = col & 1023;
        float v[8];
#pragma unroll
        for (int e = 0; e < 8; ++e) { const int m = (k1 * (n0 + e)) & 2047; const float ang = (float)m * (1.0f / 1024.0f); v[e] = cs ? -sinpif(ang) : cospif(ang); }
        v4u o; o.x = pk2(v[0], v[1]); o.y = pk2(v[2], v[3]); o.z = pk2(v[4], v[5]); o.w = pk2(v[6], v[7]);
        *(GAS v4u*)(T2 + (size_t)i * 8) = o;
    }
    for (int i = gt; i < 512 * 256 / 8; i += NGT) {
        const int row = i >> 5, c0 = (i & 31) * 8, cs = row >> 8, k2 = row & 255;
        float v[8];
#pragma unroll
        for (int e = 0; e < 8; ++e) { const int m = (k2 * (c0 + e)) & 255; const float ang = (float)m * (1.0f / 128.0f); v[e] = cs ? sinpif(ang) : cospif(ang); }
        v4u o; o.x = pk2(v[0], v[1]); o.y = pk2(v[2], v[3]); o.z = pk2(v[4], v[5]); o.w = pk2(v[6], v[7]);
        *(GAS v4u*)(TW + (size_t)i * 8) = o;
    }
}

template <bool RES, bool HOUT, bool CTX, bool XIN16, bool XOUT16, bool H8, bool ALT = false, bool MODRAW = false>
__device__ __forceinline__ void thin_phase(Frame& F, const void* xl, const void* xc, const bf16* Yb, const bf16* YC, void* ol, bf16* H, float* SA, float* PA,
                                           const float* gpost, const float* modr, int gate_ch, float coef, const float* gpre, const float* modn, int sh_ch, int sc_ch,
                                           const float* MODPr = nullptr, const float* modb = nullptr) {
    auto modv = [&](int row, int ch, int i) -> float {
        if (!MODRAW) return modn[(row * 9 + ch) * DM + i];
        const int n = ch * DM + i; float s = modb[n];
#pragma unroll
        for (int kb = 0; kb < 8; ++kb) s += MODPr[((size_t)kb * 9 + row) * NMOD + n];
        return s; };
    const int lane = lane_now(), tid = F.wave * 64 + lane; (void)tid; (void)lane;
    LAS float* VA = (LAS float*)F.lds;
    LAS float* VB = VA + 2 * DM;
    LAS float* VC = VB + 2 * DM;
    for (int vb = blockIdx.x; vb < 256; vb += F.G) {
        const int b = vb >> 5;
        __syncthreads();
        for (int i = tid; i < DM; i += NWAVES * 64) {
            if (RES) { const float gp = coef * gpost[i]; VA[i] = gp * modr[(b * 9 + gate_ch) * DM + i]; if (CTX) VA[DM + i] = gp * modr[(8 * 9 + gate_ch) * DM + i]; }
            if (HOUT) { const float gq = gpre[i]; VB[i] = gq * (1.0f + modv(b, sc_ch, i)); VC[i] = modv(b, sh_ch, i);
                if (CTX) { VB[DM + i] = gq * (1.0f + modv(8, sc_ch, i)); VC[DM + i] = modv(8, sh_ch, i); } }
        }
        __syncthreads();
        f32x4 alt[8];
#pragma unroll
        for (int j = 0; j < 8; ++j) alt[j] = (f32x4){0.f, 0.f, 0.f, 0.f};
        constexpr bool PF = XIN16 && RES && !CTX;
        v2u xnx[8], ynx[8];
        if (PF) { const v2u* xr = (const v2u*)((const unsigned short*)xl + (size_t)(vb * 64 + F.wave) * DM) + lane; const v2u* yr = (const v2u*)(Yb + (size_t)(vb * 64 + F.wave) * DM) + lane;
#pragma unroll
            for (int j = 0; j < 8; ++j) { xnx[j] = __builtin_nontemporal_load(xr + 64 * j); ynx[j] = __builtin_nontemporal_load(yr + 64 * j); } }
        for (int rr = F.wave; rr < (CTX ? 72 : 64); rr += NWAVES) {
            const bool isctx = rr >= 64; const int lrow = isctx ? vb * 8 + (rr - 64) : vb * 64 + rr, row = isctx ? MLAT + lrow : lrow, vo = isctx ? DM / 4 : 0;
            f32x4 xv[8]; v2u xcu[8], ycu[8];
            if (PF) {
#pragma unroll
                for (int j = 0; j < 8; ++j) { xcu[j] = xnx[j]; ycu[j] = ynx[j]; }
                if (rr + NWAVES < 64) { const v2u* xr = (const v2u*)((const unsigned short*)xl + (size_t)(lrow + NWAVES) * DM) + lane; const v2u* yr = (const v2u*)(Yb + (size_t)(lrow + NWAVES) * DM) + lane;
#pragma unroll
                    for (int j = 0; j < 8; ++j) { xnx[j] = __builtin_nontemporal_load(xr + 64 * j); ynx[j] = __builtin_nontemporal_load(yr + 64 * j); } }
            }
            if (XIN16) { const v2u* xr = (const v2u*)((const unsigned short*)xl + (size_t)lrow * DM) + lane;
#pragma unroll
                for (int j = 0; j < 8; ++j) { const v2u w = PF ? xcu[j] : __builtin_nontemporal_load(xr + 64 * j); xv[j] = (f32x4){h_lo(w.x), h_hi(w.x), h_lo(w.y), h_hi(w.y)}; }
            } else { const f32x4* xr = (const f32x4*)((const float*)(isctx ? xc : xl) + (size_t)lrow * DM) + lane;
#pragma unroll
                for (int j = 0; j < 8; ++j) xv[j] = __builtin_nontemporal_load(xr + 64 * j); }
            if (RES) {
                f32x4 yv[8]; float ss = 0.f;
                if (!isctx) { const v2u* yr = (const v2u*)(Yb + (size_t)row * DM) + lane;
#pragma unroll
                    for (int j = 0; j < 8; ++j) { const v2u w = PF ? ycu[j] : __builtin_nontemporal_load(yr + 64 * j); yv[j] = (f32x4){bf_lo(w.x), bf_hi(w.x), bf_lo(w.y), bf_hi(w.y)}; }
                } else { const v2u* yr = (const v2u*)(YC + (size_t)lrow * DM) + lane;
#pragma unroll
                    for (int j = 0; j < 8; ++j) { const v2u w0 = yr[64 * j], w1 = yr[CSL / 4 + 64 * j], w2 = yr[2 * (CSL / 4) + 64 * j], w3 = yr[3 * (CSL / 4) + 64 * j];
                        yv[j] = (f32x4){(bf_lo(w0.x) + bf_lo(w1.x)) + (bf_lo(w2.x) + bf_lo(w3.x)), (bf_hi(w0.x) + bf_hi(w1.x)) + (bf_hi(w2.x) + bf_hi(w3.x)),
                                        (bf_lo(w0.y) + bf_lo(w1.y)) + (bf_lo(w2.y) + bf_lo(w3.y)), (bf_hi(w0.y) + bf_hi(w1.y)) + (bf_hi(w2.y) + bf_hi(w3.y))}; } }
#pragma unroll
                for (int j = 0; j < 8; ++j) ss += (yv[j].x * yv[j].x + yv[j].y * yv[j].y) + (yv[j].z * yv[j].z + yv[j].w * yv[j].w);
                const float rstd = rsqrtf(wave_sum(ss) * (1.0f / DM) + EPS);
#pragma unroll
                for (int j = 0; j < 8; ++j) { const f32x4 va = ((const LAS f32x4*)VA)[vo + 64 * j + lane]; xv[j] = xv[j] + va * yv[j] * rstd; }
                if (!isctx) {
                    if (XOUT16) { GAS v2u* orow = (GAS v2u*)((unsigned short*)ol + (size_t)lrow * DM) + lane;
#pragma unroll
                        for (int j = 0; j < 8; ++j) { v2u o; o.x = pkh2(xv[j].x, xv[j].y); o.y = pkh2(xv[j].z, xv[j].w); __builtin_nontemporal_store(o, orow + 64 * j);
                            if (HOUT) xv[j] = (f32x4){h_lo(o.x), h_hi(o.x), h_lo(o.y), h_hi(o.y)}; }
                    } else { f32x4* orow = (f32x4*)((float*)ol + (size_t)lrow * DM) + lane;
#pragma unroll
                        for (int j = 0; j < 8; ++j) orow[64 * j] = xv[j]; }
                }
            }
            if (HOUT) {
                float ss = 0.f;
#pragma unroll
                for (int j = 0; j < 8; ++j) ss += (xv[j].x * xv[j].x + xv[j].y * xv[j].y) + (xv[j].z * xv[j].z + xv[j].w * xv[j].w);
                const float rstd = rsqrtf(wave_sum(ss) * (1.0f / DM) + EPS);
                if (H8) {
                    float am = 0.f;
#pragma unroll
                    for (int j = 0; j < 8; ++j) { const f32x4 vb4 = ((const LAS f32x4*)VB)[vo + 64 * j + lane], vc4 = ((const LAS f32x4*)VC)[vo + 64 * j + lane];
                        xv[j] = xv[j] * rstd * vb4 + vc4; am = fmaxf(fmaxf(am, fmaxf(fabsf(xv[j].x), fabsf(xv[j].y))), fmaxf(fabsf(xv[j].z), fabsf(xv[j].w))); }
#pragma unroll
                    for (int o = 1; o < 64; o <<= 1) am = fmaxf(am, __shfl_xor(am, o));
                    const float inv = am > 0.f ? 127.0f / am : 0.f;
                    if (lane == 0) SA[row] = am > 0.f ? am * (1.0f / 127.0f) : 1.0f;
                    GAS unsigned* hrow = (GAS unsigned*)((unsigned char*)H + (size_t)row * DM) + lane;
#pragma unroll
                    for (int j = 0; j < 8; ++j) hrow[64 * j] = ((unsigned)(int)__builtin_rintf(xv[j].x * inv) & 0xffu) | (((unsigned)(int)__builtin_rintf(xv[j].y * inv) & 0xffu) << 8)
                                                             | (((unsigned)(int)__builtin_rintf(xv[j].z * inv) & 0xffu) << 16) | ((unsigned)(int)__builtin_rintf(xv[j].w * inv) << 24);
                } else {
                GAS v2u* hrow = (GAS v2u*)(H + (size_t)row * DM) + lane;
#pragma unroll
                for (int j = 0; j < 8; ++j) { const f32x4 vb4 = ((const LAS f32x4*)VB)[vo + 64 * j + lane], vc4 = ((const LAS f32x4*)VC)[vo + 64 * j + lane];
                    const f32x4 h = xv[j] * rstd * vb4 + vc4; v2u o; o.x = pk2(h.x, h.y); o.y = pk2(h.z, h.w); hrow[64 * j] = o;
                    if (ALT) alt[j] += (lrow & 1) ? -h : h; }
                }
            }
        }
        if (ALT) {
            LAS float* AL = VC + 2 * DM;
#pragma unroll
            for (int j = 0; j < 8; ++j) *(LAS f32x4*)(AL + F.wave * DM + 4 * (64 * j + lane)) = alt[j];
            __syncthreads();
            for (int i = tid; i < DM; i += NWAVES * 64) { float s = 0.f;
#pragma unroll
                for (int w = 0; w < 8; ++w) s += AL[w * DM + i];
                PA[(size_t)vb * DM + i] = s; }
        }
    }
    __syncthreads();
}

__device__ __forceinline__ void fold_row(const v2u (&xr)[8], const v2u (&yr)[8], unsigned short* XSp, int lrow, int lane, const LAS float* VA, const LAS float* VB, const LAS float* VC, f32x4 (&h)[8]) {
    f32x4 yv[8]; float ss = 0.f;
#pragma unroll
    for (int j = 0; j < 8; ++j) { h[j] = (f32x4){h_lo(xr[j].x), h_hi(xr[j].x), h_lo(xr[j].y), h_hi(xr[j].y)}; yv[j] = (f32x4){bf_lo(yr[j].x), bf_hi(yr[j].x), bf_lo(yr[j].y), bf_hi(yr[j].y)}; }
#pragma unroll
    for (int j = 0; j < 8; ++j) ss += (yv[j].x * yv[j].x + yv[j].y * yv[j].y) + (yv[j].z * yv[j].z + yv[j].w * yv[j].w);
    const float rstd = rsqrtf(wave_sum(ss) * (1.0f / DM) + EPS);
    GAS v2u* orow = (GAS v2u*)(XSp + (size_t)lrow * DM) + lane;
    float s2 = 0.f;
#pragma unroll
    for (int j = 0; j < 8; ++j) { const f32x4 va = ((const LAS f32x4*)VA)[64 * j + lane]; const f32x4 xn = h[j] + va * yv[j] * rstd;
        v2u o; o.x = pkh2(xn.x, xn.y); o.y = pkh2(xn.z, xn.w); __builtin_nontemporal_store(o, orow + 64 * j);
        h[j] = (f32x4){h_lo(o.x), h_hi(o.x), h_lo(o.y), h_hi(o.y)};
        s2 += (h[j].x * h[j].x + h[j].y * h[j].y) + (h[j].z * h[j].z + h[j].w * h[j].w); }
    const float rstd2 = rsqrtf(wave_sum(s2) * (1.0f / DM) + EPS);
#pragma unroll
    for (int j = 0; j < 8; ++j) { const f32x4 vb4 = ((const LAS f32x4*)VB)[64 * j + lane], vc4 = ((const LAS f32x4*)VC)[64 * j + lane]; h[j] = h[j] * rstd2 * vb4 + vc4; }
}
__device__ __forceinline__ void thin_fold_phase(Frame& F, unsigned short* XSp, const bf16* Yb, bf16* H, float* PA, float* HN2,
                                                const float* gpost, const float* modr, int gate_ch, float coef, const float* gpre, const float* modn, int sh_ch, int sc_ch) {
    const int lane = lane_now(), tid = F.wave * 64 + lane; (void)tid; (void)lane;
    LAS float* VA = (LAS float*)F.lds; LAS float* VB = VA + 2 * DM; LAS float* VC = VB + 2 * DM;
    for (int vb = blockIdx.x; vb < 256; vb += F.G) {
        const int b = vb >> 5, jb = vb & 31;
        __syncthreads();
        for (int i = tid; i < DM; i += NWAVES * 64) {
            VA[i] = coef * gpost[i] * modr[(b * 9 + gate_ch) * DM + i];
            VB[i] = gpre[i] * (1.0f + modn[(b * 9 + sc_ch) * DM + i]); VC[i] = modn[(b * 9 + sh_ch) * DM + i]; }
        __syncthreads();
        f32x4 alt[8];
#pragma unroll
        for (int j = 0; j < 8; ++j) alt[j] = (f32x4){0.f, 0.f, 0.f, 0.f};
        v2u xc[8], yc[8], xn[8], yn[8];
        { const int n0 = 32 * jb + F.wave; const v2u* p0 = (const v2u*)(XSp + (size_t)(b * SEQ + n0) * DM) + lane; const v2u* p1 = (const v2u*)(Yb + (size_t)(b * SEQ + n0) * DM) + lane;
#pragma unroll
          for (int j = 0; j < 8; ++j) { xc[j] = __builtin_nontemporal_load(p0 + 64 * j); yc[j] = __builtin_nontemporal_load(p1 + 64 * j); } }
        for (int rr = F.wave; rr < 32; rr += NWAVES) {
            const int n = 32 * jb + rr, m = n ? SEQ - n : SEQ / 2, rowa = b * SEQ + n, rowb = b * SEQ + m;
            { const v2u* p2 = (const v2u*)(XSp + (size_t)rowb * DM) + lane; const v2u* p3 = (const v2u*)(Yb + (size_t)rowb * DM) + lane;
#pragma unroll
              for (int j = 0; j < 8; ++j) { xn[j] = __builtin_nontemporal_load(p2 + 64 * j); yn[j] = __builtin_nontemporal_load(p3 + 64 * j); } }
            f32x4 hA[8], hB[8];
            fold_row(xc, yc, XSp, rowa, lane, VA, VB, VC, hA);
            asm volatile("" ::: "memory");
            if (rr + NWAVES < 32) { const int rown = rowa + NWAVES; const v2u* p0 = (const v2u*)(XSp + (size_t)rown * DM) + lane; const v2u* p1 = (const v2u*)(Yb + (size_t)rown * DM) + lane;
#pragma unroll
                for (int j = 0; j < 8; ++j) { xc[j] = __builtin_nontemporal_load(p0 + 64 * j); yc[j] = __builtin_nontemporal_load(p1 + 64 * j); } }
            fold_row(xn, yn, XSp, rowb, lane, VA, VB, VC, hB);
            GAS v2u* srow = (GAS v2u*)(H + (size_t)(b * SEQ + n) * DM) + lane; GAS v2u* drow = (GAS v2u*)(H + (size_t)(b * SEQ + SEQ / 2 + n) * DM) + lane;
            if (n) {
#pragma unroll
                for (int j = 0; j < 8; ++j) { const f32x4 hs = hA[j] + hB[j], hd = hA[j] - hB[j]; v2u o; o.x = pk2(hs.x, hs.y); o.y = pk2(hs.z, hs.w); srow[64 * j] = o;
                    v2u q; q.x = pk2(hd.x, hd.y); q.y = pk2(hd.z, hd.w); drow[64 * j] = q; alt[j] += (n & 1) ? -hs : hs; }
            } else {
                f32x4* nrow = (f32x4*)(HN2 + (size_t)b * DM) + lane;
#pragma unroll
                for (int j = 0; j < 8; ++j) { v2u o; o.x = pk2(hA[j].x, hA[j].y); o.y = pk2(hA[j].z, hA[j].w); srow[64 * j] = o; drow[64 * j] = (v2u){0u, 0u}; nrow[64 * j] = hB[j]; alt[j] += hA[j] + hB[j]; }
            }
        }
        {
            LAS float* AL = VC + 2 * DM;
#pragma unroll
            for (int j = 0; j < 8; ++j) *(LAS f32x4*)(AL + F.wave * DM + 4 * (64 * j + lane)) = alt[j];
            __syncthreads();
            for (int i = tid; i < DM; i += NWAVES * 64) { float s = 0.f;
#pragma unroll
                for (int w = 0; w < 8; ++w) s += AL[w * DM + i];
                PA[(size_t)vb * DM + i] = s; }
        }
    }
    __syncthreads();
}

constexpr int VROW = 272;
constexpr int SC_IMG = 64 * VROW, SC_CTX = 4 * SC_IMG;
static_assert(SC_CTX + 4 * SC_IMG <= 143360 && 259 * 256 <= 4 * SC_IMG, "scan LDS");
__device__ __forceinline__ int rho_of(int t) { return 16 * ((t >> 2) & 3) + 4 * (t >> 4) + (t & 3); }
__device__ __forceinline__ void scan_phase(Frame& F, const bf16* VCV, const bf16* VC, bf16* G, bf16* YP, const bf16* GW, const float* conv_w, const float* conv_b, const float* gate_b, const float* lam) {
    const int lane = lane_now(), tid = F.wave * 64 + lane; (void)tid; (void)lane;
    const int hb = F.wave >> 2, wv = F.wave & 3, th = tid & 255, jj = lane & 15, g = lane >> 4, d = hb;
    LAS unsigned char* CTXI = F.lds;
    LAS unsigned char* IMG = F.lds + SC_CTX + hb * 2 * SC_IMG;
    LAS unsigned char* RAW = F.lds + SC_CTX;
    for (int u = blockIdx.x; u < 256; u += F.G) {
        const int b = u >> 5, q = u & 31, hd = q >> 1, half = q & 1, ch0 = hd * 128, jl = half * 64 + wv * 16 + jj, cj = ch0 + jl;
        const int col16 = tid & 15;
        __syncthreads();
        if (tid < 48) *(LAS v4u*)(RAW + ((tid >> 4) == 2 ? 258 : (tid >> 4)) * 256 + col16 * 16) = (v4u){0u, 0u, 0u, 0u};
#pragma unroll 2
        for (int it = 0; it < 8; ++it) { const int tok = (tid >> 4) + 32 * it; const bf16* p = VC + (size_t)(b * CTXL + tok) * DM + ch0 + 8 * col16;
            const v4u p0 = *(const v4u*)p, p1 = *(const v4u*)(p + CSL), p2 = *(const v4u*)(p + 2 * CSL), p3 = *(const v4u*)(p + 3 * CSL);
            v4u w;
            w.x = pk2((bf_lo(p0.x) + bf_lo(p1.x)) + (bf_lo(p2.x) + bf_lo(p3.x)), (bf_hi(p0.x) + bf_hi(p1.x)) + (bf_hi(p2.x) + bf_hi(p3.x)));
            w.y = pk2((bf_lo(p0.y) + bf_lo(p1.y)) + (bf_lo(p2.y) + bf_lo(p3.y)), (bf_hi(p0.y) + bf_hi(p1.y)) + (bf_hi(p2.y) + bf_hi(p3.y)));
            w.z = pk2((bf_lo(p0.z) + bf_lo(p1.z)) + (bf_lo(p2.z) + bf_lo(p3.z)), (bf_hi(p0.z) + bf_hi(p1.z)) + (bf_hi(p2.z) + bf_hi(p3.z)));
            w.w = pk2((bf_lo(p0.w) + bf_lo(p1.w)) + (bf_lo(p2.w) + bf_lo(p3.w)), (bf_hi(p0.w) + bf_hi(p1.w)) + (bf_hi(p2.w) + bf_hi(p3.w)));
            *(LAS v4u*)(RAW + (tok + 2) * 256 + col16 * 16) = w; }
        __syncthreads();
        { float cw[4][8], cb[8];
#pragma unroll
          for (int e = 0; e < 8; ++e) { cb[e] = conv_b[ch0 + 8 * col16 + e];
#pragma unroll
              for (int k = 0; k < 4; ++k) cw[k][e] = conv_w[k * DM + ch0 + 8 * col16 + e]; }
#pragma unroll 2
          for (int it = 0; it < 8; ++it) { const int tok = (tid >> 4) + 32 * it; float o[8];
#pragma unroll
              for (int e = 0; e < 8; ++e) o[e] = cb[e];
#pragma unroll
              for (int kk = 0; kk < 4; ++kk) { const v4u r = *(const LAS v4u*)(RAW + (tok + kk) * 256 + col16 * 16);
                  o[0] += cw[kk][0] * bf_lo(r.x); o[1] += cw[kk][1] * bf_hi(r.x); o[2] += cw[kk][2] * bf_lo(r.y); o[3] += cw[kk][3] * bf_hi(r.y);
                  o[4] += cw[kk][4] * bf_lo(r.z); o[5] += cw[kk][5] * bf_hi(r.z); o[6] += cw[kk][6] * bf_lo(r.w); o[7] += cw[kk][7] * bf_hi(r.w); }
              v4u w; w.x = pk2(o[0], o[1]); w.y = pk2(o[2], o[3]); w.z = pk2(o[4], o[5]); w.w = pk2(o[6], o[7]);
              *(LAS v4u*)(CTXI + (tok >> 6) * SC_IMG + rho_of(tok & 63) * VROW + col16 * 16) = w; } }
        constexpr float NL2E = -1.4426950408889634f;
        const float nba = NL2E * gate_b[(d * 2 + 0) * DM + cj], nbx = NL2E * gate_b[(d * 2 + 1) * DM + cj];
        const float lm = lam[d * DM + cj];
        const float sp = fmaxf(-lm, 0.f) + log1pf(__expf(-fabsf(lm)));
        const float cneg2 = -8.0f * sp * 1.4426950408889634f;
        bf16x8 Bf[2][4];
#pragma unroll
        for (int gt = 0; gt < 2; ++gt)
#pragma unroll
            for (int s = 0; s < 4; ++s) Bf[gt][s] = *(const bf16x8*)(GW + ((size_t)((d * 2 + gt) * 16 + hd) * 128 + jl) * 128 + 32 * s + 8 * g);
#pragma unroll
        for (int gt = 0; gt < 2; ++gt)
#pragma unroll
            for (int s = 0; s < 4; ++s) asm volatile("" : "+v"(Bf[gt][s]));
        const int trow = th >> 4;
        const unsigned eoff = (unsigned)(16 * g) * DM + (unsigned)cj;
        float carry = 0.f;
        v4u vpre[4];
        __syncthreads();
#define SCAN_CHUNK(j, isctx, cidx, rowbase) const bool isctx = (j) < 4; const int cidx = isctx ? (d ? 3 - (j) : (j)) : (d ? 35 - (j) : (j) - 4); const int rowbase = b * SEQ + 64 * cidx;
        for (int k = 0; k < 36; ++k) {
            SCAN_CHUNK(k, isctx, cidx, rowbase)
            const bool fin = !isctx && (d ? cidx <= 15 : cidx >= 16);
            bf16* const Gu = G + (size_t)rowbase * DM;
            if (k + 1 >= 4 && k + 1 < 36) {
#pragma unroll
                for (int it = 0; it < 4; ++it) *(LAS v4u*)(IMG + ((k + 1) & 1) * SC_IMG + rho_of(trow + 16 * it) * VROW + col16 * 16) = vpre[it]; }
            if (k + 2 >= 4 && k + 2 < 36) { SCAN_CHUNK(k + 2, pc_, pi_, pr_) (void)pc_; (void)pi_;
#pragma unroll
                for (int it = 0; it < 4; ++it) vpre[it] = *(const v4u*)(VCV + (size_t)(pr_ + trow + 16 * it) * DM + ch0 + 8 * col16); }
            float yp[16]; unsigned gg[16];
            if (fin) {
#pragma unroll
                for (int i = 0; i < 16; ++i) gg[i] = Gu[eoff + (unsigned)i * DM];
                { const v4u* ypt = (const v4u*)(YP + ((size_t)(b * DM + cj) * SEQ + 64 * cidx + 16 * g)); const v4u y0 = ypt[0], y1 = ypt[1];
                  yp[0] = bf_lo(y0.x); yp[1] = bf_hi(y0.x); yp[2] = bf_lo(y0.y); yp[3] = bf_hi(y0.y); yp[4] = bf_lo(y0.z); yp[5] = bf_hi(y0.z); yp[6] = bf_lo(y0.w); yp[7] = bf_hi(y0.w);
                  yp[8] = bf_lo(y1.x); yp[9] = bf_hi(y1.x); yp[10] = bf_lo(y1.y); yp[11] = bf_hi(y1.y); yp[12] = bf_lo(y1.z); yp[13] = bf_hi(y1.z); yp[14] = bf_lo(y1.w); yp[15] = bf_hi(y1.w); }
            }
            const LAS unsigned char* VCk = isctx ? (const LAS unsigned char*)(CTXI + cidx * SC_IMG) : (const LAS unsigned char*)(IMG + (k & 1) * SC_IMG);
            f32x4 Cr[4], Ci[4];
#pragma unroll
            for (int m = 0; m < 4; ++m) { Cr[m] = (f32x4){0.f, 0.f, 0.f, 0.f}; Ci[m] = (f32x4){0.f, 0.f, 0.f, 0.f}; }
#pragma unroll
            for (int s = 0; s < 4; ++s)
#pragma unroll
                for (int m = 0; m < 4; ++m) { const bf16x8 a = *(const LAS bf16x8*)(VCk + (16 * m + jj) * VROW + (32 * s + 8 * g) * 2);
                    Cr[m] = __builtin_amdgcn_mfma_f32_16x16x32_bf16(a, Bf[0][s], Cr[m], 0, 0, 0);
                    Ci[m] = __builtin_amdgcn_mfma_f32_16x16x32_bf16(a, Bf[1][s], Ci[m], 0, 0, 0); }
            float av[16], bv[16];
#pragma unroll
            for (int m = 0; m < 4; ++m)
#pragma unroll
                for (int r = 0; r < 4; ++r) { const int i = 4 * m + r;
                    const float vc = __uint_as_float((unsigned)(*(const LAS unsigned short*)(VCk + (16 * m + 4 * g + r) * VROW + jl * 2)) << 16);
                    const float rg = __builtin_amdgcn_rcpf(1.0f + __builtin_amdgcn_exp2f(__builtin_fmaf(Cr[m][r], NL2E, nba))), ig = __builtin_amdgcn_rcpf(1.0f + __builtin_amdgcn_exp2f(__builtin_fmaf(Ci[m][r], NL2E, nbx)));
                    const float a = __builtin_amdgcn_exp2f(rg * cneg2);
                    av[i] = a; bv[i] = __builtin_amdgcn_sqrtf(fmaxf(1.0f - a * a, 0.f)) * ig * vc; }
            float P = 1.f, Hh = 0.f;
            if (d == 0) {
#pragma unroll
                for (int i = 0; i < 16; ++i) { Hh = av[i] * Hh + bv[i]; P *= av[i]; }
            } else {
#pragma unroll
                for (int i = 15; i >= 0; --i) { Hh = av[i] * Hh + bv[i]; P *= av[i]; }
            }
            float Pk[4], Hk[4];
#pragma unroll
            for (int kk = 0; kk < 4; ++kk) { Pk[kk] = __shfl(P, jj + 16 * kk); Hk[kk] = __shfl(Hh, jj + 16 * kk); }
            float s = carry, cin = 0.f;
            if (d == 0) {
#pragma unroll
                for (int kk = 0; kk < 4; ++kk) { if (kk == g) cin = s; s = Pk[kk] * s + Hk[kk]; }
            } else {
#pragma unroll
                for (int kk = 3; kk >= 0; --kk) { if (kk == g) cin = s; s = Pk[kk] * s + Hk[kk]; }
            }
            carry = s;
            if (!isctx) {
                float h = cin;
                if (d == 0) {
#pragma unroll
                    for (int i = 0; i < 16; ++i) { h = av[i] * h + bv[i]; av[i] = h; }
                } else {
#pragma unroll
                    for (int i = 15; i >= 0; --i) { h = av[i] * h + bv[i]; av[i] = h; }
                }
                if (fin) {
#pragma unroll
                    for (int i = 0; i < 16; i += 2) { const unsigned w = pg8::cvt_pk_bf16(__uint_as_float(gg[i] << 16) * (av[i] + yp[i]), __uint_as_float(gg[i + 1] << 16) * (av[i + 1] + yp[i + 1]));
                        Gu[eoff + (unsigned)i * DM] = (bf16)(w & 0xffffu); Gu[eoff + (unsigned)(i + 1) * DM] = (bf16)(w >> 16); }
                } else {
                    { v4u* ypt = (v4u*)(YP + ((size_t)(b * DM + cj) * SEQ + 64 * cidx + 16 * g)); v4u y0, y1;
                      y0.x = pk2(av[0], av[1]); y0.y = pk2(av[2], av[3]); y0.z = pk2(av[4], av[5]); y0.w = pk2(av[6], av[7]);
                      y1.x = pk2(av[8], av[9]); y1.y = pk2(av[10], av[11]); y1.z = pk2(av[12], av[13]); y1.w = pk2(av[14], av[15]); ypt[0] = y0; ypt[1] = y1; }
                }
            }
            if (k == 19) VM_WAIT();
            __syncthreads();
        }
#undef SCAN_CHUNK
    }
}

struct Args { const float* in[17]; float* out; unsigned char* ws; };
__global__ void __launch_bounds__(NWAVES * 64, 2) fwd_kernel(Args args) {
    extern __shared__ __attribute__((aligned(16))) unsigned char lds[];
    Frame F;
    F.lds = (LAS unsigned char*)lds;
    F.MISC = (volatile LAS unsigned*)(F.lds + MISC_OFF);
    F.wave = __builtin_amdgcn_readfirstlane((int)threadIdx.x >> 6);
    F.G = gridDim.x;
    const int lane = lane_now(), tid = F.wave * 64 + lane; (void)lane;
    unsigned char* ws = args.ws;
    F.ctl = (gu32*)(ws + WS_CTL);
    for (int u = tid; u < (LDS_BYTES - LDSCTL_OFF) / 4; u += NWAVES * 64) ((LAS unsigned*)(F.lds + LDSCTL_OFF))[u] = 0u;
    __syncthreads();
    XcdBarrier bar = xcd_barrier_post((unsigned*)(F.ctl + CW_BAR), F.MISC + 8, F.wave);
#ifdef PROBE_TS
    volatile LAS unsigned long long* TS = (volatile LAS unsigned long long*)(F.lds + MISC_OFF + 128);
    int ts_n = 0;
    volatile LAS unsigned long long* TC = TS + 32;
#define GRID_BAR() do { xcd_barrier(bar); if (tid == 0) { TS[ts_n] = __builtin_amdgcn_s_memrealtime(); TC[ts_n] = (unsigned long long)clock64(); } ++ts_n; } while (0)
    if (tid == 0) { TS[ts_n] = __builtin_amdgcn_s_memrealtime(); TC[ts_n] = (unsigned long long)clock64(); } ++ts_n;
#else
#define GRID_BAR() xcd_barrier(bar)
#endif

    const float* x_in = args.in[0]; const float* c_in = args.in[1]; const float* ctx_in = args.in[2]; const float* cctx_in = args.in[3];
    const float* mod_w = args.in[4]; const float* mod_b = args.in[5]; const float* norm_g = args.in[6];
    unsigned char* WinQ = (unsigned char*)(ws + WS_WIN); float* SW = (float*)(ws + WS_SW); float* SA = (float*)(ws + WS_SA); float* PA = (float*)(ws + WS_PA); float* HN2 = (float*)(ws + WS_HN2); float* EN2 = (float*)(ws + WS_EN2); float* const PAn = nullptr; bf16* WoutT = (bf16*)(ws + WS_WOUT); bf16* WrinT = (bf16*)(ws + WS_WRIN); bf16* WroutT = (bf16*)(ws + WS_WROUT); bf16* WfouT = (bf16*)(ws + WS_WFOU);
    bf16* GW = (bf16*)(ws + WS_GW); bf16* T2 = (bf16*)(ws + WS_T2); bf16* TW = (bf16*)(ws + WS_TW);
    float* MODP = (float*)(ws + WS_MODP); float* MOD = (float*)(ws + WS_MOD);
    unsigned short* XS = (unsigned short*)(ws + WS_XS);     bf16* H = (bf16*)(ws + WS_H); bf16* ACT = (bf16*)(ws + WS_ACT); bf16* Yb = (bf16*)(ws + WS_Y); bf16* YP = (bf16*)(ws + WS_Y + 64 * MiB);
    bf16* YC = (bf16*)(ws + WS_YC); bf16* VC = (bf16*)(ws + WS_VC);
    bf16* Gb = ACT; bf16* Vb = ACT + (size_t)MALL * DM;
    bf16* ZT = ACT; bf16* Fb = ACT + (size_t)BATCH * DM * 4096; bf16* PB = (bf16*)(ws + WS_Y + 64 * MiB);
    const float* MOD0 = MOD; const float* MOD1 = MOD + 9 * NMOD;
#define NG(l, i) (norm_g + ((l) * 6 + (i)) * DM)
#define GREP1(...) __VA_ARGS__
#define GREP2(...) __VA_ARGS__ __VA_ARGS__
#if defined(PROBE_GEMM2)
#define GREP(...) GREP2(__VA_ARGS__)
#else
#define GREP(...) GREP1(__VA_ARGS__)
#endif
#if defined(PROBE_FFNIN2)
#define GREP_IN(...) GREP2(__VA_ARGS__)
#else
#define GREP_IN(...) GREP(__VA_ARGS__)
#endif
#if defined(PROBE_FFNOUT2)
#define GREP_OUT(...) GREP2(__VA_ARGS__)
#else
#define GREP_OUT(...) GREP(__VA_ARGS__)
#endif
    const int cid = (int)blockIdx.x;

    p0_adaln(F, c_in, cctx_in, mod_w, MODP);
    p0_quant_win(F, args.in[7], WinQ, SW);
    { WeightPtrs P{args.in[8], args.in[9], args.in[15], args.in[16], args.in[12], WoutT, WrinT, WroutT, WfouT, GW}; p0_weights(F, P); }
    p0_twiddles(F, T2, TW);
    GRID_BAR();
    p0_adaln_reduce(F, MODP, mod_b, MOD);
    thin_phase<false, true, true, false, false, true, false, true>(F, x_in, ctx_in, nullptr, nullptr, nullptr, H, SA, PAn, nullptr, nullptr, 0, 0.f, NG(0, 0), MOD0, 0, 1, MODP, mod_b);
    GRID_BAR();
    GREP({ pg8::Gemm g{H, (const bf16*)WinQ, DM / 2, DM / 2, DM / 2, 1, 0, 0, 0, 0}; pg8::BatchOrder S; S.init(MALL, 2 * DFF, 1, F.G, cid); pg8::EpiSwiGLU8 E{ACT, DFF, SA, SW};
      pg8::gemm_phase<pg8::EpiSwiGLU8, pg8::BatchOrder, true, true, true>(F.lds + RING_OFF, g, S, E, F.wave); })
    GRID_BAR();
    GREP_OUT({ pg8::Gemm g{ACT, WoutT, 64, DFF, DFF, 1, 0, 0, 0, 0, 32768, (long)(DFF / 64) * 32768}; pg8::BatchOrder S; S.init(MLAT, DM, 1, F.G, cid); pg8::EpiBf16Z E{Yb, DM, 0, 1.0f};
      pg8::gemm_phase<pg8::EpiBf16Z, pg8::BatchOrder, true, true>(F.lds + RING_OFF, g, S, E, F.wave); })
    GREP({ pg8::Gemm g{ACT + (size_t)MLAT * DFF, WoutT, 64, DFF, DFF / 4, 1, (long)(DFF / 4 / 64) * 32768, 0, (DFF / 4) * 2, 0, 32768, (long)(DFF / 64) * 32768}; pg8::BatchOrder S; S.init(MCTX, DM, 4, F.G, cid); pg8::EpiBf16Z E{YC, DM, MCTX, 1.0f};
      pg8::gemm_phase<pg8::EpiBf16Z, pg8::BatchOrder, true, true>(F.lds + RING_OFF, g, S, E, F.wave); })
    GRID_BAR();
    thin_phase<true, true, true, false, true, false>(F, x_in, ctx_in, Yb, YC, XS, H, SA, PAn, NG(0, 1), MOD0, 2, 0.5f, NG(0, 2), MOD0, 3, 4);
    GRID_BAR();
    GREP({ pg8::Gemm g{H, WrinT, DM, DM, DM, 1, 0, 0, 0, 0}; pg8::BatchOrder S; S.init(MLAT, 2 * DM, 1, F.G, cid); pg8::EpiGV E{Gb, Vb, args.in[10], args.in[11]};
      pg8::gemm_phase<pg8::EpiGV, pg8::BatchOrder, true, true>(F.lds + RING_OFF, g, S, E, F.wave); })
    GREP({ pg8::Gemm g{H + (size_t)MLAT * DM, WrinT + (size_t)DM * DM, DM, DM, DM / 4, 1, (DM / 4) * 2, 0, (DM / 4) * 2, 0}; pg8::BatchOrder S; S.init(MCTX, DM, 4, F.G, cid); pg8::EpiBf16Z E{VC, DM, MCTX, 1.0f};
      pg8::gemm_phase<pg8::EpiBf16Z, pg8::BatchOrder, true, true>(F.lds + RING_OFF, g, S, E, F.wave); })
    GRID_BAR();
    scan_phase(F, Vb, VC, Gb, YP, GW, args.in[10], args.in[11], args.in[13], args.in[14]);
    GRID_BAR();
    GREP({ pg8::Gemm g{Gb, WroutT, DM, DM, DM, 1, 0, 0, 0, 0}; pg8::BatchOrder S; S.init(MLAT, DM, 1, F.G, cid); pg8::EpiBf16Z E{Yb, DM, 0, 1.0f};
      pg8::gemm_phase<pg8::EpiBf16Z, pg8::BatchOrder, true, true>(F.lds + RING_OFF, g, S, E, F.wave); })
    GRID_BAR();
    thin_phase<true, true, false, true, true, true>(F, XS, nullptr, Yb, nullptr, XS, H, SA, PAn, NG(0, 3), MOD0, 5, 1.0f, NG(0, 4), MOD0, 6, 7);
    GRID_BAR();
#ifdef PROBE_CLK
    volatile LAS unsigned long long* PC = (volatile LAS unsigned long long*)(F.lds + MISC_OFF + 512);
    if (tid == 0) { PC[0] = (unsigned long long)clock64(); PC[1] = __builtin_amdgcn_s_memrealtime(); }
#endif
    GREP_IN({ pg8::Gemm g{H, (const bf16*)(WinQ + 1 * WIN_ELEMS), DM / 2, DM / 2, DM / 2, 1, 0, 0, 0, 0}; pg8::BatchOrder S; S.init(MLAT, 2 * DFF, 1, F.G, cid); pg8::EpiSwiGLU8 E{ACT, DFF, SA, SW + 1 * 2 * DFF};
      pg8::gemm_phase<pg8::EpiSwiGLU8, pg8::BatchOrder, true, true, true>(F.lds + RING_OFF, g, S, E, F.wave); })
#ifdef PROBE_CLK
    if (tid == 0) { PC[2] = (unsigned long long)clock64(); PC[3] = __builtin_amdgcn_s_memrealtime(); }
#endif
    GRID_BAR();
    GREP_OUT({ pg8::Gemm g{ACT, WoutT + WOUT_ELEMS, 64, DFF, DFF, 1, 0, 0, 0, 0, 32768, (long)(DFF / 64) * 32768}; pg8::BatchOrder S; S.init(MLAT, DM, 1, F.G, cid); pg8::EpiBf16Z E{Yb, DM, 0, 1.0f};
      pg8::gemm_phase<pg8::EpiBf16Z, pg8::BatchOrder, true, true>(F.lds + RING_OFF, g, S, E, F.wave); })
    GRID_BAR();
    thin_phase<true, true, false, true, true, true>(F, XS, nullptr, Yb, nullptr, XS, H, SA, PAn, NG(0, 5), MOD0, 8, 0.5f, NG(1, 0), MOD1, 0, 1);
    GRID_BAR();
    GREP_IN({ pg8::Gemm g{H, (const bf16*)(WinQ + 2 * WIN_ELEMS), DM / 2, DM / 2, DM / 2, 1, 0, 0, 0, 0}; pg8::BatchOrder S; S.init(MLAT, 2 * DFF, 1, F.G, cid); pg8::EpiSwiGLU8 E{ACT, DFF, SA, SW + 2 * 2 * DFF};
      pg8::gemm_phase<pg8::EpiSwiGLU8, pg8::BatchOrder, true, true, true>(F.lds + RING_OFF, g, S, E, F.wave); })
    GRID_BAR();
    GREP_OUT({ pg8::Gemm g{ACT, WoutT + 2 * WOUT_ELEMS, 64, DFF, DFF, 1, 0, 0, 0, 0, 32768, (long)(DFF / 64) * 32768}; pg8::BatchOrder S; S.init(MLAT, DM, 1, F.G, cid); pg8::EpiBf16Z E{Yb, DM, 0, 1.0f};
      pg8::gemm_phase<pg8::EpiBf16Z, pg8::BatchOrder, true, true>(F.lds + RING_OFF, g, S, E, F.wave); })
    GRID_BAR();
    thin_fold_phase(F, XS, Yb, H, PA, HN2, NG(1, 1), MOD1, 2, 0.5f, NG(1, 2), MOD1, 3, 4);
    GRID_BAR();
    for (int bid = (int)blockIdx.x; bid < 64; bid += F.G) {
        const int b = bid >> 3, g = bid & 7; LAS float* A = (LAS float*)F.lds; LAS float* A2 = A + 256; LAS float* CT = A + 512;
        const int tid = F.wave * 64 + lane_now();
        if (tid < 256) { float s = 0.f;
#pragma unroll 8
            for (int j = 0; j < 32; ++j) s += PA[(size_t)(b * 32 + j) * DM + g * 256 + tid];
            A[tid] = s; A2[tid] = HN2[(size_t)b * DM + g * 256 + tid]; CT[tid] = cospif((float)tid * (1.0f / 128.0f)); }
        __syncthreads();
        if (tid < 256) { float s = 0.f, s2 = 0.f;
            for (int c = 0; c < 256; ++c) { const float ct = CT[(tid * c) & 255]; s += ct * A[c]; s2 += ct * A2[c]; }
            Fb[((size_t)b * SEQ + 1024) * DM + g * 256 + tid] = (bf16)f2bf(s * (0.0625f * 0.02209708691207961f));
            EN2[(size_t)b * DM + g * 256 + tid] = s2 * 0.0625f; }
        __syncthreads();
    }
    GREP({ pg8::Gemm g{TW, H, 256, DM, 256, 8, 0, 0, (long)SEQ * DM * 2, 256 * 2}; pg8::ChOrder S; S.init(64, F.G, cid); pg8::EpiZT E{ZT};
      pg8::gemm_phase<pg8::EpiZT, pg8::ChOrder, true, true>(F.lds + RING_OFF, g, S, E, F.wave); })
    GRID_BAR();
    GREP({ pg8::Gemm g{T2, ZT, 2048, 2048, 1024, 1, 0, 0, (long)DM * 2048 * 2, 0}; pg8::BatchOrder S; S.init(1024, DM, 8, F.G, cid); pg8::EpiBf16Z E{PB, DM, 1024, 1.0f};
      pg8::gemm_phase<pg8::EpiBf16Z, pg8::BatchOrder, true, true>(F.lds + RING_OFF, g, S, E, F.wave); })
    VM_WAIT(); __syncthreads();
    GREP({ pg8::Gemm g{T2 + 1024, ZT + 1024, 2048, 2048, 1024, 1, 0, 0, (long)DM * 2048 * 2, 0}; pg8::BatchOrder S; S.init(1024, DM, 8, F.G, cid); pg8::EpiQ E{PB, Fb, EN2, 0.02209708691207961f};
      pg8::gemm_phase<pg8::EpiQ, pg8::BatchOrder, true, true>(F.lds + RING_OFF, g, S, E, F.wave); })
    GRID_BAR();
    GREP({ pg8::Gemm g{Fb, WfouT, DM, DM, DM, 1, 0, 0, 0, 0}; pg8::BatchOrder S; S.init(MLAT, DM, 1, F.G, cid); pg8::EpiBf16Z E{Yb, DM, 0, 1.0f};
      pg8::gemm_phase<pg8::EpiBf16Z, pg8::BatchOrder, true, true>(F.lds + RING_OFF, g, S, E, F.wave); })
    GRID_BAR();
    thin_phase<true, true, false, true, true, true>(F, XS, nullptr, Yb, nullptr, XS, H, SA, PAn, NG(1, 3), MOD1, 5, 1.0f, NG(1, 4), MOD1, 6, 7);
    GRID_BAR();
    GREP_IN({ pg8::Gemm g{H, (const bf16*)(WinQ + 3 * WIN_ELEMS), DM / 2, DM / 2, DM / 2, 1, 0, 0, 0, 0}; pg8::BatchOrder S; S.init(MLAT, 2 * DFF, 1, F.G, cid); pg8::EpiSwiGLU8 E{ACT, DFF, SA, SW + 3 * 2 * DFF};
      pg8::gemm_phase<pg8::EpiSwiGLU8, pg8::BatchOrder, true, true, true>(F.lds + RING_OFF, g, S, E, F.wave); })
    GRID_BAR();
    GREP_OUT({ pg8::Gemm g{ACT, WoutT + 3 * WOUT_ELEMS, 64, DFF, DFF, 1, 0, 0, 0, 0, 32768, (long)(DFF / 64) * 32768}; pg8::BatchOrder S; S.init(MLAT, DM, 1, F.G, cid); pg8::EpiBf16Z E{Yb, DM, 0, 1.0f};
      pg8::gemm_phase<pg8::EpiBf16Z, pg8::BatchOrder, true, true>(F.lds + RING_OFF, g, S, E, F.wave); })
    GRID_BAR();
    thin_phase<true, false, false, true, false, false>(F, XS, nullptr, Yb, nullptr, args.out, nullptr, nullptr, nullptr, NG(1, 5), MOD1, 8, 0.5f, nullptr, nullptr, 0, 0);
#ifdef PROBE_TS
    GRID_BAR();
    if (blockIdx.x == 0 && tid == 0) {
        unsigned long long tot = 0;
        for (int i = 0; i < 23; ++i) if ((PROBE_MASK >> i) & 1u) tot += TS[i + 1] - TS[i];
#ifdef PROBE_MHZ_OF
        tot = ((TC[PROBE_MHZ_OF + 1] - TC[PROBE_MHZ_OF]) * 100ull / (TS[PROBE_MHZ_OF + 1] - TS[PROBE_MHZ_OF])) * 100ull;
#endif
        const unsigned long long t0 = __builtin_amdgcn_s_memrealtime();
        while (__builtin_amdgcn_s_memrealtime() - t0 < tot) __builtin_amdgcn_s_sleep(8);
    }
#endif
#ifdef PROBE_CLK
    if (blockIdx.x == 0 && tid == 0) {
        const unsigned long long dc = PC[2] - PC[0], dr = PC[3] - PC[1];
        const unsigned long long us = PROBE_CLK_WHAT == 0 ? (dc * 100ull) / (dr ? dr : 1ull) : dr / 100ull;
        const unsigned long long t0 = __builtin_amdgcn_s_memrealtime();
        while (__builtin_amdgcn_s_memrealtime() - t0 < us * 100ull) __builtin_amdgcn_s_sleep(8);
    }
#endif
#undef NG
#undef GRID_BAR
}

extern "C" void kernel_launch(void* const* d_in, const int* in_sizes, int n_in, void* d_out, int out_size, void* d_ws, size_t ws_size, hipStream_t stream) {
    static int grid = 0;
    if (grid == 0) {
        if (n_in != 17 || in_sizes[0] != MLAT * DM || out_size != MLAT * DM || ws_size < WS_END) {
            fprintf(stderr, "kernel_launch: unexpected problem (n_in %d, in0 %d, out %d, ws %zu; need ws >= %zu); nothing launched\n", n_in, n_in > 0 ? in_sizes[0] : -1, out_size, ws_size, (size_t)WS_END); grid = -1; return; }
        int dev = 0, cus = 0, per_cu = 0;
        if (hipGetDevice(&dev) != hipSuccess || hipDeviceGetAttribute(&cus, hipDeviceAttributeMultiprocessorCount, dev) != hipSuccess) { fprintf(stderr, "kernel_launch: device query failed\n"); grid = -1; return; }
        if (hipFuncSetAttribute((const void*)fwd_kernel, hipFuncAttributeMaxDynamicSharedMemorySize, LDS_BYTES) != hipSuccess) { fprintf(stderr, "kernel_launch: hipFuncSetAttribute failed\n"); grid = -1; return; }
        if (hipOccupancyMaxActiveBlocksPerMultiprocessor(&per_cu, (const void*)fwd_kernel, NWAVES * 64, LDS_BYTES) != hipSuccess || per_cu < 1)
            fprintf(stderr, "kernel_launch: note: occupancy query reports %d workgroups per CU\n", per_cu);
        (void)hipGetLastError();
        grid = cus < 256 ? cus : 256;
    }
    if (grid < 0) return;
    if (hipMemsetAsync((char*)d_ws + WS_CTL, 0, CTL_ZERO_BYTES, stream) != hipSuccess) { fprintf(stderr, "kernel_launch: hipMemsetAsync failed\n"); return; }
    Args a{};
    for (int i = 0; i < 17; ++i) a.in[i] = (const float*)d_in[i];
    a.out = (float*)d_out; a.ws = (unsigned char*)d_ws;
    hipLaunchKernelGGL(fwd_kernel, dim3(grid), dim3(NWAVES * 64), LDS_BYTES, stream, a);
    const hipError_t le = hipPeekAtLastError();
    if (le != hipSuccess) fprintf(stderr, "kernel_launch: launch failed: %s\n", hipGetErrorName(le));
}
```
